# Optimizing an MI355X kernel written in HIP

```python
import jax
import jax.numpy as jnp
from jax import lax
import numpy as np

D_MODEL = 1024
BATCH = 16
SEQ = 2048
DEPTH = 4

CHUNK = 64
MEM_TOKENS = 256
N_EVEN = (DEPTH + 1) // 2
N_ODD = DEPTH // 2
EPS = 1e-6

A_HEADS = 4
A_HEAD_DIM = D_MODEL // 8
A_WIDTH = A_HEADS * A_HEAD_DIM
A_SUB = 8
A_NSUB = CHUNK // A_SUB

B_HEADS = 8
B_HEAD_DIM = D_MODEL // 16
B_WIDTH = B_HEADS * B_HEAD_DIM
B_PREV_CHUNKS = 8
B_BAND = B_PREV_CHUNKS + 1
REL_CLIP = 2 * CHUNK

AB_IN = 4 * A_WIDTH + 3 * B_WIDTH
AB_OUT = A_WIDTH + B_WIDTH
AB_SPLITS = (A_WIDTH, 2 * A_WIDTH, 3 * A_WIDTH, 4 * A_WIDTH,
             4 * A_WIDTH + B_WIDTH, 4 * A_WIDTH + 2 * B_WIDTH)

C_HEADS = 16
C_HEAD_DIM = D_MODEL // C_HEADS
C_WIDTH = C_HEADS * C_HEAD_DIM
C_IN = 3 * C_WIDTH + C_HEADS
Q_BLOCK = 128
FOX_BIAS_CENTER = 3.0

X_HEADS = 4
X_HEAD_DIM = D_MODEL // X_HEADS
X_WIDTH = X_HEADS * X_HEAD_DIM

D_FF = 4 * D_MODEL

kernel_name = 'hybrid_hgrn2_chunkattn_fox_encoder'


def rms_norm(x, gain):
    xf = x.astype(jnp.float32)
    y = xf * lax.rsqrt(jnp.mean(xf * xf, axis=-1, keepdims=True) + EPS)
    return (y * gain.astype(jnp.float32)).astype(x.dtype)


def split_heads(t, n_heads):
    return t.reshape(t.shape[0], t.shape[1], n_heads, -1)


def hgrn2_chunkwise(q, f_logit, i_val, lb):
    bsz, seq = q.shape[:2]
    n_chunks = seq // CHUNK
    z = f_logit.astype(jnp.float32)
    lb = lb.astype(jnp.float32)
    log_f = jnp.log(lb + (1.0 - lb) * jax.nn.sigmoid(z))
    k = (1.0 - lb) * jax.nn.sigmoid(-z)
    q = jax.nn.silu(q.astype(jnp.float32)) * A_HEAD_DIM ** -0.5
    v = i_val.astype(jnp.float32)

    def blocks(t):
        t = t.reshape(bsz, n_chunks, A_NSUB, A_SUB, A_HEADS, t.shape[-1])
        return t.transpose(0, 4, 1, 2, 3, 5)

    q, k, v, log_f = blocks(q), blocks(k), blocks(v), blocks(log_f)
    shp = log_f.shape
    b = jnp.cumsum(log_f.reshape(shp[:3] + (CHUNK, A_HEAD_DIM)), axis=3).reshape(shp)

    b_last = b[:, :, :, -1, -1]
    k_to_end = k * jnp.exp(b_last[:, :, :, None, None] - b)
    chunk_upd = jnp.einsum('bhnisk,bhnisv->bhnkv', k_to_end, v)

    def step(state, inp):
        decay, upd = inp
        return decay[..., None] * state + upd, state

    state0 = jnp.zeros((bsz, A_HEADS, A_HEAD_DIM, A_HEAD_DIM), jnp.float32)
    _, s_start = lax.scan(step, state0,
                          (jnp.moveaxis(jnp.exp(b_last), 2, 0), jnp.moveaxis(chunk_upd, 2, 0)))
    s_start = jnp.moveaxis(s_start, 0, 2)
    o = jnp.einsum('bhnitk,bhnkv->bhnitv', q * jnp.exp(b), s_start)

    r = b[:, :, :, :, -1]
    sub = jnp.arange(A_NSUB)
    earlier = (sub[:, None] > sub[None, :])[:, None, :, None]
    expo = b[:, :, :, :, :, None, :] - r[:, :, :, None, None, :, :]
    q_ref = q[:, :, :, :, :, None, :] * jnp.exp(jnp.where(earlier, expo, -jnp.inf))
    k_ref = k * jnp.exp(r[:, :, :, :, None, :] - b)
    a_off = jnp.einsum('bhnitjk,bhnjsk->bhnitjs', q_ref, k_ref)
    o = o + jnp.einsum('bhnitjs,bhnjsv->bhnitv', a_off, v)

    tri = jnp.tril(jnp.ones((A_SUB, A_SUB), dtype=bool))[:, :, None]
    pair = b[:, :, :, :, :, None, :] - b[:, :, :, :, None, :, :]
    decay = jnp.exp(jnp.where(tri, pair, -jnp.inf))
    a_diag = jnp.einsum('bhnitk,bhnitsk,bhnisk->bhnits', q, decay, k)
    o = o + jnp.einsum('bhnits,bhnisv->bhnitv', a_diag, v)
    return o.transpose(0, 2, 3, 4, 1, 5).reshape(bsz, seq, A_WIDTH)


def chunk_band_attention(q, k, v, rel_table):
    bsz, seq, n_heads, dh = q.shape
    n_chunks = seq // CHUNK
    qc = q.reshape(bsz, n_chunks, CHUNK, n_heads, dh)
    pad = ((0, 0), (B_PREV_CHUNKS, 0), (0, 0), (0, 0), (0, 0))
    kc = jnp.pad(k.reshape(bsz, n_chunks, CHUNK, n_heads, dh), pad)
    vc = jnp.pad(v.reshape(bsz, n_chunks, CHUNK, n_heads, dh), pad)
    band_idx = jnp.arange(n_chunks)[:, None] + jnp.arange(B_BAND)[None, :]
    kb = kc[:, band_idx].reshape(bsz, n_chunks, B_BAND * CHUNK, n_heads, dh)
    vb = vc[:, band_idx].reshape(bsz, n_chunks, B_BAND * CHUNK, n_heads, dh)
    logits = jnp.einsum('bnqhd,bnkhd->bhnqk', qc, kb).astype(jnp.float32) * dh ** -0.5
    offs = jnp.arange(B_BAND * CHUNK)
    rel = B_PREV_CHUNKS * CHUNK + jnp.arange(CHUNK)[:, None] - offs[None, :]
    rel_idx = jnp.clip(rel, -REL_CLIP, REL_CLIP) + REL_CLIP
    bias = rel_table.astype(jnp.float32)[:, rel_idx]
    valid = (jnp.arange(n_chunks)[:, None] - B_PREV_CHUNKS + offs[None, :] // CHUNK) >= 0
    logits = jnp.where(valid[None, None, :, None, :], logits + bias[None, :, None], -jnp.inf)
    p = jax.nn.softmax(logits, axis=-1).astype(v.dtype)
    out = jnp.einsum('bhnqk,bnkhd->bnqhd', p, vb)
    return out.reshape(bsz, seq, n_heads * dh)


def forgetting_attention(q, k, v, f_logit):
    bsz, seq, n_heads, dh = q.shape
    n_blocks = seq // Q_BLOCK
    cum = jnp.cumsum(jax.nn.log_sigmoid(f_logit.astype(jnp.float32)), axis=1)
    cum_k = cum.transpose(0, 2, 1)
    q_blocks = q.reshape(bsz, n_blocks, Q_BLOCK, n_heads, dh).transpose(1, 0, 2, 3, 4)
    c_blocks = cum.reshape(bsz, n_blocks, Q_BLOCK, n_heads).transpose(1, 0, 3, 2)
    pos_q = jnp.arange(seq).reshape(n_blocks, Q_BLOCK)
    pos_k = jnp.arange(seq)

    def one_block(args):
        q_blk, c_blk, p_blk = args
        s = jnp.einsum('bqhd,bkhd->bhqk', q_blk, k).astype(jnp.float32) * dh ** -0.5
        s = s + c_blk[..., None] - cum_k[:, :, None, :]
        s = jnp.where((p_blk[:, None] >= pos_k[None, :])[None, None], s, -jnp.inf)
        p = jax.nn.softmax(s, axis=-1).astype(v.dtype)
        return jnp.einsum('bhqk,bkhd->bqhd', p, v)

    out = lax.map(one_block, (q_blocks, c_blocks, pos_q))
    return out.transpose(1, 0, 2, 3, 4).reshape(bsz, seq, n_heads * dh)


def hgrn2_chunkattn_mixer(xn, w_in, lb, a_gain, rel_table, w_out):
    h = xn @ w_in
    q_a, f_a, i_a, g_a, q_b, k_b, v_b = jnp.split(h, AB_SPLITS, axis=-1)
    o_a = hgrn2_chunkwise(split_heads(q_a, A_HEADS), split_heads(f_a, A_HEADS),
                          split_heads(i_a, A_HEADS), lb.reshape(A_HEADS, A_HEAD_DIM))
    o_a = rms_norm(split_heads(o_a, A_HEADS), a_gain.reshape(A_HEADS, A_HEAD_DIM)).reshape(o_a.shape)
    o_a = (o_a * jax.nn.silu(g_a.astype(jnp.float32))).astype(xn.dtype)
    o_b = chunk_band_attention(split_heads(q_b, B_HEADS), split_heads(k_b, B_HEADS),
                               split_heads(v_b, B_HEADS), rel_table)
    return jnp.concatenate([o_a, o_b], axis=-1) @ w_out


def forgetting_mixer(xn, w_in, f_bias, w_out):
    h = xn @ w_in
    q, k, v, f = jnp.split(h, (C_WIDTH, 2 * C_WIDTH, 3 * C_WIDTH), axis=-1)
    o = forgetting_attention(split_heads(q, C_HEADS), split_heads(k, C_HEADS),
                             split_heads(v, C_HEADS), f + f_bias)
    return o @ w_out


def memory_cross_attention(xn, mem_n, w_q, w_kv, w_o):
    q = split_heads(xn @ w_q, X_HEADS)
    k, v = jnp.split(mem_n @ w_kv, 2, axis=-1)
    k, v = split_heads(k, X_HEADS), split_heads(v, X_HEADS)
    s = jnp.einsum('bqhd,bkhd->bhqk', q, k).astype(jnp.float32) * X_HEAD_DIM ** -0.5
    p = jax.nn.softmax(s, axis=-1).astype(v.dtype)
    o = jnp.einsum('bhqk,bkhd->bqhd', p, v)
    return o.reshape(xn.shape[0], xn.shape[1], X_WIDTH) @ w_o


def squared_relu_mlp(xn, w_up, w_down):
    return jnp.square(jax.nn.relu(xn @ w_up)) @ w_down


def setup_inputs(seed: int = 0) -> dict:
    key = jax.random.key(seed)
    ks = jax.random.split(key, 20)
    f32 = jnp.float32

    def dense(k, shape):
        return jax.random.normal(k, shape, f32) * shape[-2] ** -0.5

    def gain(k, shape):
        return 1.0 + 0.05 * jax.random.normal(k, shape, f32)

    return {
        'x': jax.random.normal(ks[0], (BATCH, SEQ, D_MODEL), f32),
        'mem': jax.random.normal(ks[1], (BATCH, MEM_TOKENS, D_MODEL), f32),
        'norm_mix': gain(ks[2], (DEPTH, D_MODEL)),
        'norm_xattn': gain(ks[3], (DEPTH, D_MODEL)),
        'norm_mem': gain(ks[4], (DEPTH, D_MODEL)),
        'norm_mlp': gain(ks[5], (DEPTH, D_MODEL)),
        'norm_final': gain(ks[6], (D_MODEL,)),
        'w_in_ab': dense(ks[7], (N_EVEN, D_MODEL, AB_IN)),
        'a_lb_logits': 0.5 * jax.random.normal(ks[8], (N_EVEN, A_WIDTH), f32),
        'a_out_gain': gain(ks[9], (N_EVEN, A_WIDTH)),
        'b_rel_bias': 0.2 * jax.random.normal(ks[10], (N_EVEN, B_HEADS, 2 * REL_CLIP + 1), f32),
        'w_out_ab': dense(ks[11], (N_EVEN, AB_OUT, D_MODEL)),
        'w_in_c': dense(ks[12], (N_ODD, D_MODEL, C_IN)),
        'c_fgate_bias': FOX_BIAS_CENTER + 0.5 * jax.random.normal(ks[13], (N_ODD, C_HEADS), f32),
        'w_out_c': dense(ks[14], (N_ODD, C_WIDTH, D_MODEL)),
        'w_xq': dense(ks[15], (DEPTH, D_MODEL, X_WIDTH)),
        'w_xkv': dense(ks[16], (DEPTH, D_MODEL, 2 * X_WIDTH)),
        'w_xo': dense(ks[17], (DEPTH, X_WIDTH, D_MODEL)),
        'w_up': dense(ks[18], (DEPTH, D_MODEL, D_FF)),
        'w_down': dense(ks[19], (DEPTH, D_FF, D_MODEL)),
    }


def reference(x, mem, norm_mix, norm_xattn, norm_mem, norm_mlp, norm_final,
              w_in_ab, a_lb_logits, a_out_gain, b_rel_bias, w_out_ab,
              w_in_c, c_fgate_bias, w_out_c, w_xq, w_xkv, w_xo, w_up, w_down):
    lb_w = jax.nn.softmax(a_lb_logits.astype(jnp.float32), axis=0)
    lower_bounds = jnp.cumsum(lb_w, axis=0) - lb_w[0]
    h = x
    for layer in range(DEPTH):
        xn = rms_norm(h, norm_mix[layer])
        if layer % 2 == 0:
            e = layer // 2
            mix = hgrn2_chunkattn_mixer(xn, w_in_ab[e], lower_bounds[e], a_out_gain[e],
                                        b_rel_bias[e], w_out_ab[e])
        else:
            o = layer // 2
            mix = forgetting_mixer(xn, w_in_c[o], c_fgate_bias[o], w_out_c[o])
        h = h + mix
        h = h + memory_cross_attention(rms_norm(h, norm_xattn[layer]), rms_norm(mem, norm_mem[layer]),
                                       w_xq[layer], w_xkv[layer], w_xo[layer])
        h = h + squared_relu_mlp(rms_norm(h, norm_mlp[layer]), w_up[layer], w_down[layer])
    return rms_norm(h, norm_final)
```

```cpp
#include <hip/hip_runtime.h>
#include <hip/hip_cooperative_groups.h>
#include <cstdio>
#include <cstdint>
namespace cg = cooperative_groups;

#define LAS __attribute__((address_space(3)))
typedef unsigned short bf16_t;
typedef short bf16x8 __attribute__((ext_vector_type(8)));
typedef float f32x4 __attribute__((ext_vector_type(4)));
typedef float f32x16 __attribute__((ext_vector_type(16)));
typedef unsigned u32x4 __attribute__((ext_vector_type(4)));
typedef unsigned u32x2 __attribute__((ext_vector_type(2)));

constexpr int D = 1024, NB = 16, SEQ = 2048, T = NB * SEQ, DEPTH = 4, CHUNK = 64, MEMT = 256, TM = NB * MEMT;
constexpr int AH = 4, AD = 128, BH = 8, BD = 64, AB_IN = 3584, CH = 16, CD = 64, C_IN = 3088, C_INP = 3328, XH = 4, XD = 256, FF = 4096;
constexpr float EPS = 1e-6f;
constexpr float LOG2E = 1.4426950408889634f;
constexpr int COL_QA = 0, COL_QB = 512, COL_FA = 1024, COL_IA = 1536, COL_GA = 2048, COL_KB = 2560, COL_VB = 3072;
constexpr int COL_CQ = 0, COL_CK = 1024, COL_CV = 2048, COL_CF = 3072;

constexpr size_t MiB = 1ull << 20;
constexpr size_t WS_RSS = 1 * MiB, WS_RSTDM = 3 * MiB, WS_FOXC = 4 * MiB, WS_DEC = 6 * MiB, WS_MEMB = 8 * MiB, WS_MEMKV = 16 * MiB;
constexpr size_t WS_W0 = 32 * MiB, WS_WSTRIDE = 33 * MiB, WS_HB = 98 * MiB, WS_BIG = 162 * MiB, WS_HG = 418 * MiB, WS_AMAT = 482 * MiB, WS_END = 498 * MiB;
constexpr size_t WO_IN = 0, WO_OUT = (size_t)3584 * 1024, WO_XQ = WO_OUT + 1024 * 1024, WO_XKV = WO_XQ + 1024 * 1024, WO_XO = WO_XKV + 2048 * 1024,
                 WO_UP = WO_XO + 1024 * 1024, WO_DOWN = WO_UP + (size_t)4096 * 1024;
static_assert((WO_DOWN + (size_t)4096 * 1024) * 2 <= WS_WSTRIDE, "weight buffer");

constexpr int LDS_BYTES = 147456;

__device__ __forceinline__ float bf2f(bf16_t v) { return __uint_as_float(((unsigned)v) << 16); }
__device__ __forceinline__ unsigned f2bf(float f) { unsigned u = __float_as_uint(f); return (u + 0x7fffu + ((u >> 16) & 1u)) >> 16; }
__device__ __forceinline__ unsigned pk2(float lo, float hi) { return f2bf(lo) | (f2bf(hi) << 16); }
__device__ __forceinline__ float wave_sum(float v) {
#pragma unroll
    for (int o = 1; o < 64; o <<= 1) v += __shfl_xor(v, o);
    return v;
}
__device__ __forceinline__ float wave_max(float v) {
#pragma unroll
    for (int o = 1; o < 64; o <<= 1) v = fmaxf(v, __shfl_xor(v, o));
    return v;
}
#define LDS_WAIT() asm volatile("s_waitcnt lgkmcnt(0)" ::: "memory")

namespace pg8 {
constexpr int BM = 256, BK = 64, HALF = 128, HTB = HALF * BK * 2, STAGE_BYTES = 8 * HTB, NXCD = 8, WGM = 8;
__host__ __device__ __forceinline__ int lds_byte(int r, int c) { const int st = (r >> 4) * 2 + (c >> 5), rr = r & 15, cc = c & 31, ob = rr * 64 + cc * 2; return st * 1024 + (ob ^ (((ob >> 9) & 1) << 5)); }
__host__ __device__ __forceinline__ void stage_rc(int b, int& R, int& C) { const int st = b / 1024, sb = b % 1024, swz = sb ^ (((sb >> 9) & 1) << 5); R = (st >> 1) * 16 + swz / 64; C = (st & 1) * 32 + (swz % 64) / 2; }
__host__ __device__ __forceinline__ int perm32(int rho) { const int n = rho >> 4, i = rho & 15; return 8 * (i >> 2) + 4 * n + (i & 3); }

struct Unit { int pm, pn; };
struct Gemm { const bf16_t* A; const bf16_t* Bt; };

struct StaticOrder {
    int nM, nN, nwg, G, c;
    __host__ __device__ void init(int M, int N, int G_, int c_) { nM = M / BM; nN = N / BM; nwg = nM * nN; G = G_; c = c_; }
    __host__ __device__ bool next(int i, Unit& u) const {
        const long L = (long)i * G + c; if (L >= nwg) return false;
        int wgid = (int)L; { const int q = nwg / NXCD, r = nwg % NXCD, xcd = wgid % NXCD, off = wgid / NXCD; wgid = (xcd < r ? xcd * (q + 1) : r * (q + 1) + (xcd - r) * q) + off; }
        const int nig = WGM * nN, gid = wgid / nig, fm = gid * WGM, gsz = (nM - fm) < WGM ? (nM - fm) : WGM;
        u.pm = fm + ((wgid % nig) % gsz); u.pn = (wgid % nig) / gsz; return true;
    }
};
__device__ __forceinline__ unsigned cvt_pk_bf16(float lo, float hi) { unsigned r; asm volatile("v_cvt_pk_bf16_f32 %0, %1, %2" : "=v"(r) : "v"(lo), "v"(hi)); return r; }

template <int mode, int act, int ldc> struct EpiScale {
    static constexpr bool PERM = true;
    bf16_t* O; const float* rs;
    __device__ __forceinline__ void operator()(const f32x4 (&acc)[2][2][4][2], const Unit& u, int wr, int wc, int fr, int fq) const {
        const int row0 = u.pm * BM + wr * 64 + fr, col0 = u.pn * BM + wc * 32 + 8 * fq;
#pragma unroll
        for (int ai = 0; ai < 2; ++ai)
#pragma unroll
            for (int m = 0; m < 4; ++m) {
                const int row = row0 + ai * HALF + m * 16;
                float rstd;
                if (mode == 0) { const f32x4* p = (const f32x4*)(rs + (size_t)row * 16); const f32x4 a = p[0], b = p[1], c = p[2], d = p[3];
                    const float ss = ((a[0] + a[1]) + (a[2] + a[3])) + ((b[0] + b[1]) + (b[2] + b[3])) + ((c[0] + c[1]) + (c[2] + c[3])) + ((d[0] + d[1]) + (d[2] + d[3]));
                    rstd = rsqrtf(ss * (1.0f / D) + EPS); }
                else rstd = rs[row];
                bf16_t* rowp = O + (size_t)row * ldc + col0;
#pragma unroll
                for (int bj = 0; bj < 2; ++bj) { f32x4 v0 = acc[ai][bj][m][0] * rstd, v1 = acc[ai][bj][m][1] * rstd;
                    if (act) {
#pragma unroll
                        for (int e = 0; e < 4; ++e) { const float a0 = fmaxf(v0[e], 0.f), a1 = fmaxf(v1[e], 0.f); v0[e] = a0 * a0; v1[e] = a1 * a1; } }
                    u32x4 w; w.x = cvt_pk_bf16(v0[0], v0[1]); w.y = cvt_pk_bf16(v0[2], v0[3]); w.z = cvt_pk_bf16(v1[0], v1[1]); w.w = cvt_pk_bf16(v1[2], v1[3]);
                    *(u32x4*)(rowp + bj * HALF) = w; }
            }
    }
};
struct EpiRes {
    static constexpr bool PERM = false;
    const float* base; float* out; bf16_t* hb; float* rss;
    __device__ __forceinline__ void operator()(const f32x4 (&acc)[2][2][4][2], const Unit& u, int wr, int wc, int fr, int fq) const {
        const int row0 = u.pm * BM + wr * 64 + fr, col0 = u.pn * BM + wc * 32 + 4 * fq;
#pragma unroll
        for (int ai = 0; ai < 2; ++ai)
#pragma unroll
            for (int m = 0; m < 4; ++m) {
                const int row = row0 + ai * HALF + m * 16; const size_t off = (size_t)row * D + col0; float ss = 0.f;
#pragma unroll
                for (int bj = 0; bj < 2; ++bj)
#pragma unroll
                    for (int n = 0; n < 2; ++n) { const size_t o2 = off + bj * HALF + n * 16; const f32x4 b = *(const f32x4*)(base + o2); const f32x4 o = b + acc[ai][bj][m][n];
                        *(f32x4*)(out + o2) = o; ss += (o[0] * o[0] + o[1] * o[1]) + (o[2] * o[2] + o[3] * o[3]);
                        u32x2 w; w.x = cvt_pk_bf16(o[0], o[1]); w.y = cvt_pk_bf16(o[2], o[3]); *(u32x2*)(hb + o2) = w; }
                ss += __shfl_xor(ss, 16); ss += __shfl_xor(ss, 32);
                if (fq == 0) rss[(size_t)row * 16 + u.pn * 4 + wc] = ss;
            }
    }
};

template <class Epi, class Sched, int K, int lda>
__device__ __forceinline__ void gemm_phase(LAS unsigned char* lds, const Gemm g, const Sched& S, const Epi& E, const int tid) {
    const int wid = __builtin_amdgcn_readfirstlane(tid >> 6), lane = tid & 63, wr = wid >> 2, wc = wid & 3, fr = lane & 15, fq = lane >> 4;
    constexpr int nt = K / BK;
    unsigned voffA[2], voffB[2];
#pragma unroll
    for (int i = 0; i < 2; ++i) { int R, C; stage_rc(tid * 16 + i * 8192, R, C); const int Rb = Epi::PERM ? ((R & ~31) + perm32(R & 31)) : R;
        voffA[i] = (unsigned)(R * lda + C) * 2u; voffB[i] = (unsigned)(Rb * K + C) * 2u; }
    const size_t kstep = (size_t)(BK * 2);
    const size_t hstepA = (size_t)HALF * lda * 2, hstepB = (size_t)HALF * K * 2;
    const size_t tstepA = 2 * hstepA, tstepB = 2 * hstepB;
    const unsigned ldsw = (unsigned)wid * 1024u;
    const int aoff = lds_byte(wr * 64 + fr, fq * 8), boff = lds_byte(wc * 32 + fr, fq * 8);
#define PG8_SA(b, h) (((b) * 2 + (h)) * HTB)
#define PG8_SB(b, h) ((4 + (b) * 2 + (h)) * HTB)
#define PG8_STAGE(bufoff, gbase, voff) do { _Pragma("unroll") for (int _i = 0; _i < 2; ++_i) \
        __builtin_amdgcn_global_load_lds((const unsigned*)((const char*)(gbase) + (voff)[_i]), (LAS unsigned*)(lds + (bufoff) + ldsw + _i * 8192), 16, 0, 0); } while (0)
#define PG8_LDA(dst, b, h) do { _Pragma("unroll") for (int m = 0; m < 4; ++m) _Pragma("unroll") for (int k = 0; k < 2; ++k) dst[m][k] = *(const LAS bf16x8*)(lds + PG8_SA(b, h) + aoff + m * 2048 + k * 1024); } while (0)
#define PG8_LDB(dst, b, h) do { _Pragma("unroll") for (int n = 0; n < 2; ++n) _Pragma("unroll") for (int k = 0; k < 2; ++k) dst[n][k] = *(const LAS bf16x8*)(lds + PG8_SB(b, h) + boff + n * 2048 + k * 1024); } while (0)
#define PG8_MMA(ai, bj, At, Bt) do { __builtin_amdgcn_s_setprio(1); _Pragma("unroll") for (int m = 0; m < 4; ++m) _Pragma("unroll") for (int n = 0; n < 2; ++n) _Pragma("unroll") for (int k = 0; k < 2; ++k) \
        acc[ai][bj][m][n] = __builtin_amdgcn_mfma_f32_16x16x32_bf16(Bt[n][k], At[m][k], acc[ai][bj][m][n], 0, 0, 0); __builtin_amdgcn_s_setprio(0); } while (0)
#define PG8_WAIT_V(n) asm volatile("s_waitcnt vmcnt(" #n ")" ::: "memory")
#define PG8_WAIT_L(n) asm volatile("s_waitcnt lgkmcnt(" #n ")" ::: "memory")
#define PG8_BAR __builtin_amdgcn_s_barrier()
#define PG8_SCHED __builtin_amdgcn_sched_barrier(0)
    Unit cur, nxt; int ui = 0;
    if (!S.next(0, cur)) return;
    f32x4 acc[2][2][4][2];
#pragma unroll
    for (int a = 0; a < 2; ++a)
#pragma unroll
        for (int b = 0; b < 2; ++b)
#pragma unroll
            for (int m = 0; m < 4; ++m)
#pragma unroll
                for (int n = 0; n < 2; ++n) acc[a][b][m][n] = (f32x4){0.f, 0.f, 0.f, 0.f};
    bf16x8 At[4][2], B0[2][2], B1[2][2];
    const char* cA = (const char*)g.A + (size_t)cur.pm * tstepA; const char* cB = (const char*)g.Bt + (size_t)cur.pn * tstepB;
    PG8_STAGE(PG8_SB(0, 0), cB, voffB); PG8_STAGE(PG8_SB(0, 1), cB + hstepB, voffB); PG8_STAGE(PG8_SA(0, 0), cA, voffA); PG8_STAGE(PG8_SA(0, 1), cA + hstepA, voffA);
    if (wr == 1) PG8_BAR;
    PG8_WAIT_V(2); PG8_BAR;
    PG8_STAGE(PG8_SB(1, 0), cB + kstep, voffB); PG8_STAGE(PG8_SA(1, 0), cA + kstep, voffA); PG8_STAGE(PG8_SB(1, 1), cB + hstepB + kstep, voffB);
    PG8_WAIT_V(6); PG8_BAR;
    for (;;) {
        const bool has_next = S.next(ui + 1, nxt);
        const char* nA = has_next ? (const char*)g.A + (size_t)nxt.pm * tstepA : cA; const char* nB = has_next ? (const char*)g.Bt + (size_t)nxt.pn * tstepB : cB;
        for (int t = 0; t < nt; t += 2) {
            const bool last = (t == nt - 2);
            const char* a1 = cA + (size_t)(t + 1) * kstep;
            const char* a2 = last ? nA : cA + (size_t)(t + 2) * kstep; const char* b2 = last ? nB : cB + (size_t)(t + 2) * kstep;
            const char* a3 = a2 + kstep; const char* b3 = b2 + kstep;
            PG8_LDB(B0, 0, 0); PG8_LDB(B1, 0, 1); PG8_SCHED; PG8_LDA(At, 0, 0); PG8_STAGE(PG8_SA(1, 1), a1 + hstepA, voffA);
            PG8_WAIT_V(8); PG8_WAIT_L(0); PG8_BAR; PG8_MMA(0, 0, At, B0); PG8_MMA(0, 1, At, B1); PG8_BAR; PG8_SCHED;
            PG8_LDA(At, 0, 1); PG8_STAGE(PG8_SB(0, 0), b2, voffB); PG8_STAGE(PG8_SB(0, 1), b2 + hstepB, voffB); PG8_STAGE(PG8_SA(0, 0), a2, voffA);
            PG8_WAIT_V(8); PG8_WAIT_L(0); PG8_BAR; PG8_MMA(1, 0, At, B0); PG8_MMA(1, 1, At, B1); PG8_BAR; PG8_SCHED;
            PG8_LDB(B0, 1, 0); PG8_LDB(B1, 1, 1); PG8_SCHED; PG8_LDA(At, 1, 0); PG8_STAGE(PG8_SA(0, 1), a2 + hstepA, voffA);
            PG8_WAIT_V(8); PG8_WAIT_L(0); PG8_BAR; PG8_MMA(0, 0, At, B0); PG8_MMA(0, 1, At, B1); PG8_BAR; PG8_SCHED;
            PG8_LDA(At, 1, 1); PG8_STAGE(PG8_SB(1, 0), b3, voffB); PG8_STAGE(PG8_SB(1, 1), b3 + hstepB, voffB); PG8_STAGE(PG8_SA(1, 0), a3, voffA);
            PG8_WAIT_V(8); PG8_WAIT_L(0); PG8_BAR; PG8_MMA(1, 0, At, B0); PG8_MMA(1, 1, At, B1); PG8_BAR; PG8_SCHED;
        }
        if (wr == 0) PG8_BAR;
        E(acc, cur, wr, wc, fr, fq);
        if (!has_next) break;
#pragma unroll
        for (int a = 0; a < 2; ++a)
#pragma unroll
            for (int b = 0; b < 2; ++b)
#pragma unroll
                for (int m = 0; m < 4; ++m)
#pragma unroll
                    for (int n = 0; n < 2; ++n) acc[a][b][m][n] = (f32x4){0.f, 0.f, 0.f, 0.f};
        cur = nxt; cA = nA; cB = nB; ++ui;
        if (wr == 1) PG8_BAR;
    }
    PG8_WAIT_V(0);
    PG8_BAR;
#undef PG8_SA
#undef PG8_SB
#undef PG8_STAGE
#undef PG8_LDA
#undef PG8_LDB
#undef PG8_MMA
#undef PG8_WAIT_V
#undef PG8_WAIT_L
#undef PG8_BAR
#undef PG8_SCHED
}
}

struct Args { const float* in[20]; float* out; unsigned char* ws; int ph_lo, ph_hi; };

struct Ctx {
    LAS unsigned char* lds; int tid, lane, wave, G, bid;
    const float* const* in; float* out; unsigned char* ws;
};
#define WSP(T_, off) ((T_*)(C.ws + (off)))

__device__ __forceinline__ int abmap(int n) { const int blk = n >> 9; return (int)((0x6514320u >> (4 * blk)) & 15u) * 512 + (n & 511); }
__device__ __forceinline__ void tr_item(const float* W, int K, int N, bf16_t* WT, const float* gain, int mapmode, LAS float* scr, int item, int lane) {
    const int nblk = (N + 31) / 32, kb = item / nblk, nb = item % nblk, k0 = 64 * kb, n0 = 32 * nb;
    const int nl = lane & 31, n = n0 + nl;
#pragma unroll 8
    for (int i = 0; i < 32; ++i) { const int kk = 2 * i + (lane >> 5); float v = 0.f;
        if (n < N) { v = W[(size_t)(k0 + kk) * N + n]; if (gain) v *= gain[k0 + kk]; }
        scr[kk * 33 + nl] = v; }
    LDS_WAIT();
    const int c = lane & 7;
#pragma unroll
    for (int j = 0; j < 4; ++j) { const int nn = (lane >> 3) + 8 * j, ns = n0 + nn;
        if (ns < N) { const int drow = mapmode ? abmap(ns) : ns; const LAS float* s = scr + (8 * c) * 33 + nn;
            u32x4 o; o.x = pk2(s[0 * 33], s[1 * 33]); o.y = pk2(s[2 * 33], s[3 * 33]); o.z = pk2(s[4 * 33], s[5 * 33]); o.w = pk2(s[6 * 33], s[7 * 33]);
            *(u32x4*)(WT + (size_t)drow * K + k0 + 8 * c) = o; } }
    LDS_WAIT();
}
__device__ __forceinline__ void conv_layer(const Ctx& C, int l) {
    LAS float* scr = (LAS float*)(C.lds + C.wave * 16384);
    bf16_t* WB = WSP(bf16_t, WS_W0 + (size_t)(l & 1) * WS_WSTRIDE);
    const int gw = C.bid * 8 + C.wave, NGW = C.G * 8;
    const bool even = (l & 1) == 0; const int sub = l >> 1;
    const int n_in = even ? AB_IN : C_IN;
    const int i0 = 16 * ((n_in + 31) / 32), i1 = 16 * 32, i2 = 16 * 32, i3 = 16 * 64, i4 = 16 * 32, i5 = 16 * 128, i6 = 64 * 32;
    const int tot = i0 + i1 + i2 + i3 + i4 + i5 + i6;
    for (int it = gw; it < tot; it += NGW) {
        int r = it;
        if (r < i0) { tr_item(even ? C.in[7] + (size_t)sub * D * AB_IN : C.in[12] + (size_t)sub * D * C_IN, D, n_in, WB + WO_IN, C.in[2] + l * D, even ? 1 : 0, scr, r, C.lane); continue; } r -= i0;
        if (r < i1) { tr_item(even ? C.in[11] + (size_t)sub * D * D : C.in[14] + (size_t)sub * D * D, D, D, WB + WO_OUT, nullptr, 0, scr, r, C.lane); continue; } r -= i1;
        if (r < i2) { tr_item(C.in[15] + (size_t)l * D * D, D, D, WB + WO_XQ, C.in[3] + l * D, 0, scr, r, C.lane); continue; } r -= i2;
        if (r < i3) { tr_item(C.in[16] + (size_t)l * D * 2 * D, D, 2 * D, WB + WO_XKV, C.in[4] + l * D, 0, scr, r, C.lane); continue; } r -= i3;
        if (r < i4) { tr_item(C.in[17] + (size_t)l * D * D, D, D, WB + WO_XO, nullptr, 0, scr, r, C.lane); continue; } r -= i4;
        if (r < i5) { tr_item(C.in[18] + (size_t)l * D * FF, D, FF, WB + WO_UP, C.in[5] + l * D, 0, scr, r, C.lane); continue; } r -= i5;
        tr_item(C.in[19] + (size_t)l * FF * D, FF, D, WB + WO_DOWN, nullptr, 0, scr, r, C.lane);
    }
}
__device__ __forceinline__ float row_to_bf16(const float* xrow, bf16_t* orow, int lane) {
    const f32x4* xr = (const f32x4*)xrow + lane; float s = 0.f;
    unsigned long long* o8 = (unsigned long long*)orow + lane;
#pragma unroll
    for (int j = 0; j < 4; ++j) { const f32x4 v = xr[64 * j]; s += (v[0] * v[0] + v[1] * v[1]) + (v[2] * v[2] + v[3] * v[3]);
        o8[64 * j] = (unsigned long long)pk2(v[0], v[1]) | ((unsigned long long)pk2(v[2], v[3]) << 32); }
    return wave_sum(s);
}
__device__ __forceinline__ void prologue(const Ctx& C) {
    conv_layer(C, 0);
    const int gw = C.bid * 8 + C.wave, NGW = C.G * 8;
    bf16_t* HB = WSP(bf16_t, WS_HB); float* RSS = WSP(float, WS_RSS);
    for (int m = gw; m < T; m += NGW) { const float ss = row_to_bf16(C.in[0] + (size_t)m * D, HB + (size_t)m * D, C.lane);
        if (C.lane < 16) RSS[(size_t)m * 16 + C.lane] = C.lane == 0 ? ss : 0.f; }
    bf16_t* MB = WSP(bf16_t, WS_MEMB); float* RM = WSP(float, WS_RSTDM);
    for (int m = gw; m < TM; m += NGW) { const float ss = row_to_bf16(C.in[1] + (size_t)m * D, MB + (size_t)m * D, C.lane);
        if (C.lane == 0) RM[m] = rsqrtf(ss * (1.0f / D) + EPS); }
}
__device__ __forceinline__ void final_norm(const Ctx& C) {
    const int gw = C.bid * 8 + C.wave, NGW = C.G * 8; const float* gn = C.in[6];
    for (int m = gw; m < T; m += NGW) { f32x4* xr = (f32x4*)(C.out + (size_t)m * D) + C.lane; f32x4 v[4]; float s = 0.f;
#pragma unroll
        for (int j = 0; j < 4; ++j) { v[j] = xr[64 * j]; s += (v[j][0] * v[j][0] + v[j][1] * v[j][1]) + (v[j][2] * v[j][2] + v[j][3] * v[j][3]); }
        const float rstd = rsqrtf(wave_sum(s) * (1.0f / D) + EPS);
#pragma unroll
        for (int j = 0; j < 4; ++j) { const f32x4 g4 = ((const f32x4*)gn)[C.lane + 64 * j]; xr[64 * j] = v[j] * rstd * g4; } }
}

__device__ __forceinline__ float log_sigmoid(float x) { return fminf(x, 0.f) - log1pf(__expf(-fabsf(x))); }
__device__ __forceinline__ float sigmoidf_(float x) { return 1.0f / (1.0f + __expf(-x)); }

template <int DH, int MODE>
__device__ __forceinline__ void naive_attn_row(const bf16_t* qrow, const bf16_t* Kb, const bf16_t* Vb, int ldkv, int nk, float scale,
                                               const float* tab, int rel0, const float* cum, int tpos, bf16_t* orow, LAS float* pl, LAS float* ql, int lane) {
#pragma unroll
    for (int j = 0; j < DH / 64; ++j) ql[lane + 64 * j] = bf2f(qrow[lane + 64 * j]);
    LDS_WAIT();
    float mx = -INFINITY;
    for (int k = lane; k < nk; k += 64) {
        const u32x4* kr = (const u32x4*)(Kb + (size_t)k * ldkv); float dot = 0.f;
#pragma unroll 4
        for (int c = 0; c < DH / 8; ++c) { const u32x4 w = kr[c];
#pragma unroll
            for (int e = 0; e < 4; ++e) { dot += ql[c * 8 + 2 * e] * __uint_as_float(w[e] << 16) + ql[c * 8 + 2 * e + 1] * __uint_as_float(w[e] & 0xffff0000u); } }
        float lg = dot * scale;
        if (MODE == 1) { int rel = rel0 - k; rel = rel < -128 ? -128 : (rel > 128 ? 128 : rel); lg += tab[rel + 128]; }
        if (MODE == 2) lg += cum[tpos] - cum[k];
        pl[k] = lg; mx = fmaxf(mx, lg);
    }
    mx = wave_max(mx); float sum = 0.f;
    for (int k = lane; k < nk; k += 64) { const float e = __expf(pl[k] - mx); pl[k] = e; sum += e; }
    sum = wave_sum(sum); LDS_WAIT();
    const float inv = 1.0f / sum;
#pragma unroll
    for (int j = 0; j < DH / 64; ++j) { const int d = lane + 64 * j; float a = 0.f;
        for (int k = 0; k < nk; ++k) a += pl[k] * bf2f(Vb[(size_t)k * ldkv + d]);
        orow[d] = (bf16_t)f2bf(a * inv); }
    LDS_WAIT();
}
__device__ __forceinline__ void naive_band(const Ctx& C, int e) {
    bf16_t* BIG = WSP(bf16_t, WS_BIG); const int gw = C.bid * 8 + C.wave, NGW = C.G * 8;
    LAS float* pl = (LAS float*)(C.lds + C.wave * 9216); LAS float* ql = pl + 2048;
    for (int it = gw; it < T * BH; it += NGW) { const int hd = it % BH, row = it / BH, b = row / SEQ, t = row % SEQ, cq = t / CHUNK;
        const int c0 = cq - 8 < 0 ? 0 : cq - 8, k0 = c0 * CHUNK, nk = (cq + 1) * CHUNK - k0;
        bf16_t* qp = BIG + (size_t)row * AB_IN + COL_QB + hd * BD;
        const bf16_t* kp = BIG + (size_t)(b * SEQ + k0) * AB_IN + COL_KB + hd * BD; const bf16_t* vp = BIG + (size_t)(b * SEQ + k0) * AB_IN + COL_VB + hd * BD;
        naive_attn_row<BD, 1>(qp, kp, vp, AB_IN, nk, 0.125f, C.in[10] + (size_t)(e * BH + hd) * 257, t - k0, nullptr, 0, qp, pl, ql, C.lane); }
}
__device__ __forceinline__ void naive_fox_cum(const Ctx& C, int o) {
    const bf16_t* BIG = WSP(bf16_t, WS_BIG); float* cum = WSP(float, WS_FOXC);
    const int g = C.bid * 512 + C.tid;
    if (g < NB * CH) { const int b = g / CH, hd = g % CH; const float fb = C.in[13][o * CH + hd]; float c = 0.f;
        for (int t = 0; t < SEQ; ++t) { c += log_sigmoid(bf2f(BIG[(size_t)(b * SEQ + t) * C_INP + COL_CF + hd]) + fb); cum[(size_t)g * SEQ + t] = c; } }
}
__device__ __forceinline__ void naive_fox(const Ctx& C) {
    bf16_t* BIG = WSP(bf16_t, WS_BIG); const float* cum = WSP(float, WS_FOXC); const int gw = C.bid * 8 + C.wave, NGW = C.G * 8;
    LAS float* pl = (LAS float*)(C.lds + C.wave * 9216); LAS float* ql = pl + 2048;
    for (int it = gw; it < T * CH; it += NGW) { const int hd = it % CH, row = it / CH, b = row / SEQ, t = row % SEQ;
        bf16_t* qp = BIG + (size_t)row * C_INP + COL_CQ + hd * CD;
        const bf16_t* kp = BIG + (size_t)(b * SEQ) * C_INP + COL_CK + hd * CD; const bf16_t* vp = BIG + (size_t)(b * SEQ) * C_INP + COL_CV + hd * CD;
        naive_attn_row<CD, 2>(qp, kp, vp, C_INP, t + 1, 0.125f, nullptr, 0, cum + (size_t)(b * CH + hd) * SEQ, t, qp, pl, ql, C.lane); }
}
__device__ __forceinline__ void naive_xattn(const Ctx& C) {
    bf16_t* XQ = WSP(bf16_t, WS_BIG); const bf16_t* KV = WSP(bf16_t, WS_MEMKV); const int gw = C.bid * 8 + C.wave, NGW = C.G * 8;
    LAS float* pl = (LAS float*)(C.lds + C.wave * 9216); LAS float* ql = pl + 2048;
    for (int it = gw; it < T * XH; it += NGW) { const int hd = it % XH, row = it / XH, b = row / SEQ;
        bf16_t* qp = XQ + (size_t)row * D + hd * XD;
        const bf16_t* kp = KV + (size_t)(b * MEMT) * 2 * D + hd * XD; const bf16_t* vp = kp + D;
        naive_attn_row<XD, 0>(qp, kp, vp, 2 * D, MEMT, 0.0625f, nullptr, 0, nullptr, 0, qp, pl, ql, C.lane); }
}
__device__ __forceinline__ void naive_hgrn(const Ctx& C, int e) {
    bf16_t* BIG = WSP(bf16_t, WS_BIG);
    LAS float* fL = (LAS float*)C.lds; LAS float* qL = fL + 2048; LAS float* vL = qL + 2048; LAS float* oL = vL + 2048;
    const int dv = C.tid & 127, kq = C.tid >> 7;
    for (int u = C.bid; u < NB * AH; u += C.G) { const int b = u / AH, hd = u % AH;
        float S[32];
#pragma unroll
        for (int i = 0; i < 32; ++i) S[i] = 0.f;
        for (int t0 = 0; t0 < SEQ; t0 += 16) {
            for (int idx = C.tid; idx < 2048; idx += 512) { const int r = idx >> 7, c = idx & 127; const size_t ro = (size_t)(b * SEQ + t0 + r) * AB_IN + hd * AD + c;
                float lb = 0.f; if (e == 1) { const float l0 = C.in[8][hd * AD + c], l1 = C.in[8][512 + hd * AD + c]; lb = 1.0f / (1.0f + __expf(l0 - l1)); }
                const float z = bf2f(BIG[ro + COL_FA]), q = bf2f(BIG[ro + COL_QA]);
                fL[idx] = lb + (1.0f - lb) * sigmoidf_(z); qL[idx] = q * sigmoidf_(q) * 0.08838834764831845f; vL[idx] = bf2f(BIG[ro + COL_IA]); }
            __syncthreads();
#pragma unroll 1
            for (int r = 0; r < 16; ++r) { const float v = vL[r * 128 + dv]; float po = 0.f;
#pragma unroll
                for (int i = 0; i < 32; ++i) { const float f = fL[r * 128 + kq * 32 + i]; S[i] = f * S[i] + (1.0f - f) * v; po += S[i] * qL[r * 128 + kq * 32 + i]; }
                oL[(r * 4 + kq) * 128 + dv] = po; }
            __syncthreads();
#pragma unroll
            for (int rr = 0; rr < 2; ++rr) { const int r = C.wave * 2 + rr; float o[2]; float ss = 0.f;
#pragma unroll
                for (int j = 0; j < 2; ++j) { const int d = C.lane + 64 * j; o[j] = (oL[(r * 4 + 0) * 128 + d] + oL[(r * 4 + 1) * 128 + d]) + (oL[(r * 4 + 2) * 128 + d] + oL[(r * 4 + 3) * 128 + d]); ss += o[j] * o[j]; }
                const float rstd = rsqrtf(wave_sum(ss) * (1.0f / AD) + EPS);
#pragma unroll
                for (int j = 0; j < 2; ++j) { const int d = C.lane + 64 * j; const size_t ro = (size_t)(b * SEQ + t0 + r) * AB_IN + hd * AD + d;
                    const float g = bf2f(BIG[ro + COL_GA]); const float val = o[j] * rstd * C.in[9][e * 512 + hd * AD + d] * (g * sigmoidf_(g));
                    BIG[ro + COL_QA] = (bf16_t)f2bf(val); } }
            __syncthreads();
        }
    }
}

enum { K_PRO = 0, K_INPROJ = 1, K_MIXA = 2, K_MIXB = 3, K_MIXC = 4, K_OUTPROJ = 5, K_XQ = 6, K_XATTN = 7, K_XO = 8, K_UP = 9, K_DOWN = 10, K_FINAL = 11 };
constexpr unsigned long long EVEN_KINDS = 0xA9876521ull; constexpr int N_EVEN_PH = 8;
constexpr unsigned long long ODD_KINDS = 0xA98765321ull; constexpr int N_ODD_PH = 9;
constexpr int N_PHASES = 1 + 2 * (N_EVEN_PH + N_ODD_PH) + 1;

#define GEMM_SCALE(MODE_, ACT_, M_, N_, K_, LDA_, A_, B_, O_, RS_) do { pg8::Gemm g{A_, B_}; pg8::EpiScale<MODE_, ACT_, N_> E{O_, RS_}; pg8::StaticOrder S; S.init(M_, N_, C.G, C.bid); \
        pg8::gemm_phase<pg8::EpiScale<MODE_, ACT_, N_>, pg8::StaticOrder, K_, LDA_>(C.lds, g, S, E, C.tid); } while (0)
#define GEMM_RES(K_, LDA_, A_, B_, BASE_) do { pg8::Gemm g{A_, B_}; pg8::EpiRes E{BASE_, C.out, HB, RSS}; pg8::StaticOrder S; S.init(T, D, C.G, C.bid); \
        pg8::gemm_phase<pg8::EpiRes, pg8::StaticOrder, K_, LDA_>(C.lds, g, S, E, C.tid); } while (0)
__global__ void __launch_bounds__(512, 2) mega(Args a) {
    extern __shared__ __attribute__((aligned(16))) unsigned char lds_raw[];
    Ctx C; C.lds = (LAS unsigned char*)lds_raw; C.tid = threadIdx.x; C.lane = C.tid & 63; C.wave = __builtin_amdgcn_readfirstlane(C.tid >> 6); C.G = gridDim.x; C.bid = blockIdx.x;
    C.in = a.in; C.out = a.out; C.ws = a.ws;
    cg::grid_group grid = cg::this_grid();
    for (int ph = a.ph_lo; ph < a.ph_hi; ++ph) {
        { int t_ = threadIdx.x; asm volatile("" : "+v"(t_)); C.tid = t_; C.lane = t_ & 63; C.wave = __builtin_amdgcn_readfirstlane(t_ >> 6); }
        int l = 0, kind;
        if (ph == 0) kind = K_PRO; else if (ph == N_PHASES - 1) kind = K_FINAL;
        else { const int r = ph - 1, pair = r / (N_EVEN_PH + N_ODD_PH), rr = r % (N_EVEN_PH + N_ODD_PH);
            if (rr < N_EVEN_PH) { l = 2 * pair; kind = (int)((EVEN_KINDS >> (4 * rr)) & 15ull); } else { l = 2 * pair + 1; kind = (int)((ODD_KINDS >> (4 * (rr - N_EVEN_PH))) & 15ull); } }
        const bool even = (l & 1) == 0;
        bf16_t* WB = WSP(bf16_t, WS_W0 + (size_t)(l & 1) * WS_WSTRIDE);
        bf16_t* HB = WSP(bf16_t, WS_HB); bf16_t* BIG = WSP(bf16_t, WS_BIG); float* RSS = WSP(float, WS_RSS);
        if (kind == K_PRO) prologue(C);
        else if (kind == K_FINAL) final_norm(C);
        else if (kind == K_INPROJ) {
            if (even) GEMM_SCALE(0, 0, T, AB_IN, D, D, HB, WB + WO_IN, BIG, RSS); else GEMM_SCALE(0, 0, T, C_INP, D, D, HB, WB + WO_IN, BIG, RSS);
        } else if (kind == K_XQ) {
            GEMM_SCALE(0, 0, T, D, D, D, HB, WB + WO_XQ, BIG, RSS);
            GEMM_SCALE(1, 0, TM, 2 * D, D, D, WSP(bf16_t, WS_MEMB), WB + WO_XKV, WSP(bf16_t, WS_MEMKV), WSP(float, WS_RSTDM));
        } else if (kind == K_UP) {
            GEMM_SCALE(0, 1, T, FF, D, D, HB, WB + WO_UP, BIG, RSS);
        } else if (kind == K_OUTPROJ) {
            const float* base = l == 0 ? C.in[0] : C.out;
            if (even) GEMM_RES(D, AB_IN, BIG, WB + WO_OUT, base); else GEMM_RES(D, C_INP, BIG, WB + WO_OUT, base);
        } else if (kind == K_XO) {
            GEMM_RES(D, D, BIG, WB + WO_XO, C.out);
        } else if (kind == K_DOWN) {
            GEMM_RES(FF, FF, BIG, WB + WO_DOWN, C.out);
        } else if (kind == K_MIXA) {
            if (even) { naive_hgrn(C, l >> 1); naive_band(C, l >> 1); } else naive_fox_cum(C, l >> 1);
        } else if (kind == K_MIXB) {
            naive_fox(C);
        } else if (kind == K_XATTN) {
            naive_xattn(C);
            __syncthreads();
            if (l + 1 < DEPTH) conv_layer(C, l + 1);
        }
        if (ph + 1 < a.ph_hi) grid.sync();
    }
}

#ifndef SINGLE_LAUNCH
#define SINGLE_LAUNCH 0
#endif
extern "C" void kernel_launch(void* const* d_in, const int* in_sizes, int n_in, void* d_out, int out_size, void* d_ws, size_t ws_size, hipStream_t stream) {
    static int grid = 0;
    if (grid == 0) {
        if (n_in != 20 || out_size != T * D || ws_size < WS_END) { fprintf(stderr, "kernel_launch: unexpected shapes (n_in %d out %d ws %zu)\n", n_in, out_size, ws_size); grid = -1; return; }
        int dev = 0, cus = 0, per_cu = 0;
        hipGetDevice(&dev); hipDeviceGetAttribute(&cus, hipDeviceAttributeMultiprocessorCount, dev);
        if (hipFuncSetAttribute((const void*)mega, hipFuncAttributeMaxDynamicSharedMemorySize, LDS_BYTES) != hipSuccess) { fprintf(stderr, "kernel_launch: hipFuncSetAttribute failed\n"); grid = -1; return; }
        if (hipOccupancyMaxActiveBlocksPerMultiprocessor(&per_cu, (const void*)mega, 512, LDS_BYTES) != hipSuccess || per_cu < 1) { fprintf(stderr, "kernel_launch: occupancy query says %d\n", per_cu); per_cu = 1; }
        (void)hipGetLastError();
        grid = cus * 1;
    }
    if (grid < 0) return;
    Args a{};
    for (int i = 0; i < 20; ++i) a.in[i] = (const float*)d_in[i];
    a.out = (float*)d_out; a.ws = (unsigned char*)d_ws;
#if SINGLE_LAUNCH
    a.ph_lo = 0; a.ph_hi = N_PHASES;
    void* args[] = {&a};
    hipError_t e = hipLaunchCooperativeKernel((const void*)mega, dim3(grid), dim3(512), args, LDS_BYTES, stream);
    if (e != hipSuccess) fprintf(stderr, "cooperative launch failed: %s (grid %d)\n", hipGetErrorString(e), grid);
#else
    for (int ph = 0; ph < N_PHASES; ++ph) { a.ph_lo = ph; a.ph_hi = ph + 1; hipLaunchKernelGGL(mega, dim3(grid), dim3(512), LDS_BYTES, stream, a); }
#endif
}
```

```cpp
#include <hip/hip_runtime.h>
#include <hip/hip_cooperative_groups.h>
#include <cstdio>
#include <cstdint>
namespace cg = cooperative_groups;

#define LAS __attribute__((address_space(3)))
typedef unsigned short bf16_t;
typedef short bf16x8 __attribute__((ext_vector_type(8)));
typedef float f32x4 __attribute__((ext_vector_type(4)));
typedef float f32x16 __attribute__((ext_vector_type(16)));
typedef unsigned u32x4 __attribute__((ext_vector_type(4)));
typedef unsigned u32x2 __attribute__((ext_vector_type(2)));

constexpr int D = 1024, NB = 16, SEQ = 2048, T = NB * SEQ, DEPTH = 4, CHUNK = 64, MEMT = 256, TM = NB * MEMT;
constexpr int AH = 4, AD = 128, BH = 8, BD = 64, AB_IN = 3584, CH = 16, CD = 64, C_IN = 3088, C_INP = 3328, XH = 4, XD = 256, FF = 4096;
constexpr float EPS = 1e-6f;
constexpr float LOG2E = 1.4426950408889634f;
constexpr int COL_QA = 0, COL_QB = 512, COL_FA = 1024, COL_IA = 1536, COL_GA = 2048, COL_KB = 2560, COL_VB = 3072;
constexpr int COL_CQ = 0, COL_CK = 1024, COL_CV = 2048, COL_CF = 3072;

constexpr size_t MiB = 1ull << 20;
constexpr size_t WS_RSS = 1 * MiB, WS_RSTDM = 3 * MiB, WS_FOXC = 4 * MiB, WS_DEC = 6 * MiB, WS_MEMB = 8 * MiB, WS_MEMKV = 16 * MiB;
constexpr size_t WS_W0 = 32 * MiB, WS_WSTRIDE = 33 * MiB, WS_HB = 98 * MiB, WS_BIG = 162 * MiB, WS_HG = 418 * MiB, WS_AMAT = 482 * MiB, WS_END = 498 * MiB;
constexpr size_t WO_IN = 0, WO_OUT = (size_t)3584 * 1024, WO_XQ = WO_OUT + 1024 * 1024, WO_XKV = WO_XQ + 1024 * 1024, WO_XO = WO_XKV + 2048 * 1024,
                 WO_UP = WO_XO + 1024 * 1024, WO_DOWN = WO_UP + (size_t)4096 * 1024;
static_assert((WO_DOWN + (size_t)4096 * 1024) * 2 <= WS_WSTRIDE, "weight buffer");

constexpr int LDS_BYTES = 147456;

__device__ __forceinline__ float bf2f(bf16_t v) { return __uint_as_float(((unsigned)v) << 16); }
__device__ __forceinline__ unsigned f2bf(float f) { unsigned u = __float_as_uint(f); return (u + 0x7fffu + ((u >> 16) & 1u)) >> 16; }
__device__ __forceinline__ unsigned pk2(float lo, float hi) { return f2bf(lo) | (f2bf(hi) << 16); }
__device__ __forceinline__ float wave_sum(float v) {
#pragma unroll
    for (int o = 1; o < 64; o <<= 1) v += __shfl_xor(v, o);
    return v;
}
__device__ __forceinline__ float wave_max(float v) {
#pragma unroll
    for (int o = 1; o < 64; o <<= 1) v = fmaxf(v, __shfl_xor(v, o));
    return v;
}
#define LDS_WAIT() asm volatile("s_waitcnt lgkmcnt(0)" ::: "memory")

namespace pg8 {
constexpr int BM = 256, BK = 64, HALF = 128, HTB = HALF * BK * 2, STAGE_BYTES = 8 * HTB, NXCD = 8, WGM = 8;
__host__ __device__ __forceinline__ int lds_byte(int r, int c) { const int st = (r >> 4) * 2 + (c >> 5), rr = r & 15, cc = c & 31, ob = rr * 64 + cc * 2; return st * 1024 + (ob ^ (((ob >> 9) & 1) << 5)); }
__host__ __device__ __forceinline__ void stage_rc(int b, int& R, int& C) { const int st = b / 1024, sb = b % 1024, swz = sb ^ (((sb >> 9) & 1) << 5); R = (st >> 1) * 16 + swz / 64; C = (st & 1) * 32 + (swz % 64) / 2; }
__host__ __device__ __forceinline__ int perm32(int rho) { const int n = rho >> 4, i = rho & 15; return 8 * (i >> 2) + 4 * n + (i & 3); }

struct Unit { int pm, pn; };
struct Gemm { const bf16_t* A; const bf16_t* Bt; };

struct StaticOrder {
    int nM, nN, nwg, G, c;
    __host__ __device__ void init(int M, int N, int G_, int c_) { nM = M / BM; nN = N / BM; nwg = nM * nN; G = G_; c = c_; }
    __host__ __device__ bool next(int i, Unit& u) const {
        const long L = (long)i * G + c; if (L >= nwg) return false;
        int wgid = (int)L; { const int q = nwg / NXCD, r = nwg % NXCD, xcd = wgid % NXCD, off = wgid / NXCD; wgid = (xcd < r ? xcd * (q + 1) : r * (q + 1) + (xcd - r) * q) + off; }
        const int nig = WGM * nN, gid = wgid / nig, fm = gid * WGM, gsz = (nM - fm) < WGM ? (nM - fm) : WGM;
        u.pm = fm + ((wgid % nig) % gsz); u.pn = (wgid % nig) / gsz; return true;
    }
};
__device__ __forceinline__ unsigned cvt_pk_bf16(float lo, float hi) { unsigned r; asm volatile("v_cvt_pk_bf16_f32 %0, %1, %2" : "=v"(r) : "v"(lo), "v"(hi)); return r; }

template <int mode, int act, int ldc> struct EpiScale {
    static constexpr bool PERM = true;
    bf16_t* O; const float* rs;
    __device__ __forceinline__ void operator()(const f32x4 (&acc)[2][2][4][2], const Unit& u, int wr, int wc, int fr, int fq) const {
        const int row0 = u.pm * BM + wr * 64 + fr, col0 = u.pn * BM + wc * 32 + 8 * fq;
        float rstd[8];
        if (mode == 0) {
#pragma unroll
            for (int hb2 = 0; hb2 < 2; ++hb2) { f32x4 pr[4][4];
#pragma unroll
                for (int i = 0; i < 4; ++i) { const f32x4* p = (const f32x4*)(rs + (size_t)(row0 + hb2 * HALF + i * 16) * 16);
#pragma unroll
                    for (int j = 0; j < 4; ++j) pr[i][j] = p[j]; }
#pragma unroll
                for (int i = 0; i < 4; ++i) { const f32x4 a = pr[i][0], b = pr[i][1], c = pr[i][2], d = pr[i][3];
                    const float ss = ((a[0] + a[1]) + (a[2] + a[3])) + ((b[0] + b[1]) + (b[2] + b[3])) + ((c[0] + c[1]) + (c[2] + c[3])) + ((d[0] + d[1]) + (d[2] + d[3]));
                    rstd[hb2 * 4 + i] = rsqrtf(ss * (1.0f / D) + EPS); }
                asm volatile("" ::: "memory"); }
        } else {
#pragma unroll
            for (int i = 0; i < 8; ++i) rstd[i] = rs[row0 + (i >> 2) * HALF + (i & 3) * 16];
        }
#pragma unroll
        for (int ai = 0; ai < 2; ++ai)
#pragma unroll
            for (int m = 0; m < 4; ++m) {
                const int row = row0 + ai * HALF + m * 16; const float rsd = rstd[ai * 4 + m];
                bf16_t* rowp = O + (size_t)row * ldc + col0;
#pragma unroll
                for (int bj = 0; bj < 2; ++bj) { f32x4 v0 = acc[ai][bj][m][0] * rsd, v1 = acc[ai][bj][m][1] * rsd;
                    if (act) {
#pragma unroll
                        for (int e = 0; e < 4; ++e) { const float a0 = fmaxf(v0[e], 0.f), a1 = fmaxf(v1[e], 0.f); v0[e] = a0 * a0; v1[e] = a1 * a1; } }
                    u32x4 w; w.x = cvt_pk_bf16(v0[0], v0[1]); w.y = cvt_pk_bf16(v0[2], v0[3]); w.z = cvt_pk_bf16(v1[0], v1[1]); w.w = cvt_pk_bf16(v1[2], v1[3]);
                    *(u32x4*)(rowp + bj * HALF) = w; }
            }
    }
};
struct EpiRes {
    static constexpr bool PERM = false;
    const float* base; float* out; bf16_t* hb; float* rss;
    __device__ __forceinline__ void operator()(const f32x4 (&acc)[2][2][4][2], const Unit& u, int wr, int wc, int fr, int fq) const {
        const int row0 = u.pm * BM + wr * 64 + fr, col0 = u.pn * BM + wc * 32 + 4 * fq;
#pragma unroll
        for (int ai = 0; ai < 2; ++ai)
#pragma unroll
        for (int mh = 0; mh < 2; ++mh) {
            f32x4 bv[2][2][2];
#pragma unroll
            for (int m2 = 0; m2 < 2; ++m2)
#pragma unroll
                for (int bj = 0; bj < 2; ++bj)
#pragma unroll
                    for (int n = 0; n < 2; ++n) bv[m2][bj][n] = *(const f32x4*)(base + (size_t)(row0 + ai * HALF + (2 * mh + m2) * 16) * D + col0 + bj * HALF + n * 16);
            asm volatile("" ::: "memory");
#pragma unroll
            for (int m2 = 0; m2 < 2; ++m2) { const int m = 2 * mh + m2;
                const int row = row0 + ai * HALF + m * 16; const size_t off = (size_t)row * D + col0; float ss = 0.f;
#pragma unroll
                for (int bj = 0; bj < 2; ++bj)
#pragma unroll
                    for (int n = 0; n < 2; ++n) { const size_t o2 = off + bj * HALF + n * 16; const f32x4 o = bv[m2][bj][n] + acc[ai][bj][m][n];
                        *(f32x4*)(out + o2) = o; ss += (o[0] * o[0] + o[1] * o[1]) + (o[2] * o[2] + o[3] * o[3]);
                        u32x2 w; w.x = cvt_pk_bf16(o[0], o[1]); w.y = cvt_pk_bf16(o[2], o[3]); *(u32x2*)(hb + o2) = w; }
                ss += __shfl_xor(ss, 16); ss += __shfl_xor(ss, 32);
                if (fq == 0) rss[(size_t)row * 16 + u.pn * 4 + wc] = ss;
            }
            asm volatile("" ::: "memory");
        }
    }
};

template <class Epi, class Sched, int K, int lda>
__device__ __forceinline__ void gemm_phase(LAS unsigned char* lds, const Gemm g, const Sched& S, const Epi& E, const int tid) {
    const int wid = __builtin_amdgcn_readfirstlane(tid >> 6), lane = tid & 63, wr = wid >> 2, wc = wid & 3, fr = lane & 15, fq = lane >> 4;
    constexpr int nt = K / BK;
    unsigned voffA[2], voffB[2];
#pragma unroll
    for (int i = 0; i < 2; ++i) { int R, C; stage_rc(tid * 16 + i * 8192, R, C); const int Rb = Epi::PERM ? ((R & ~31) + perm32(R & 31)) : R;
        voffA[i] = (unsigned)(R * lda + C) * 2u; voffB[i] = (unsigned)(Rb * K + C) * 2u; }
    const size_t kstep = (size_t)(BK * 2);
    const size_t hstepA = (size_t)HALF * lda * 2, hstepB = (size_t)HALF * K * 2;
    const size_t tstepA = 2 * hstepA, tstepB = 2 * hstepB;
    const unsigned ldsw = (unsigned)wid * 1024u;
    const int aoff = lds_byte(wr * 64 + fr, fq * 8), boff = lds_byte(wc * 32 + fr, fq * 8);
#define PG8_SA(b, h) (((b) * 2 + (h)) * HTB)
#define PG8_SB(b, h) ((4 + (b) * 2 + (h)) * HTB)
#define PG8_STAGE(bufoff, gbase, voff) do { _Pragma("unroll") for (int _i = 0; _i < 2; ++_i) \
        __builtin_amdgcn_global_load_lds((const unsigned*)((const char*)(gbase) + (voff)[_i]), (LAS unsigned*)(lds + (bufoff) + ldsw + _i * 8192), 16, 0, 0); } while (0)
#define PG8_LDA(dst, b, h) do { _Pragma("unroll") for (int m = 0; m < 4; ++m) _Pragma("unroll") for (int k = 0; k < 2; ++k) dst[m][k] = *(const LAS bf16x8*)(lds + PG8_SA(b, h) + aoff + m * 2048 + k * 1024); } while (0)
#define PG8_LDB(dst, b, h) do { _Pragma("unroll") for (int n = 0; n < 2; ++n) _Pragma("unroll") for (int k = 0; k < 2; ++k) dst[n][k] = *(const LAS bf16x8*)(lds + PG8_SB(b, h) + boff + n * 2048 + k * 1024); } while (0)
#define PG8_MMA(ai, bj, At, Bt) do { __builtin_amdgcn_s_setprio(1); _Pragma("unroll") for (int m = 0; m < 4; ++m) _Pragma("unroll") for (int n = 0; n < 2; ++n) _Pragma("unroll") for (int k = 0; k < 2; ++k) \
        acc[ai][bj][m][n] = __builtin_amdgcn_mfma_f32_16x16x32_bf16(Bt[n][k], At[m][k], acc[ai][bj][m][n], 0, 0, 0); __builtin_amdgcn_s_setprio(0); } while (0)
#define PG8_WAIT_V(n) asm volatile("s_waitcnt vmcnt(" #n ")" ::: "memory")
#define PG8_WAIT_L(n) asm volatile("s_waitcnt lgkmcnt(" #n ")" ::: "memory")
#define PG8_BAR __builtin_amdgcn_s_barrier()
#define PG8_SCHED __builtin_amdgcn_sched_barrier(0)
    Unit cur, nxt; int ui = 0;
    if (!S.next(0, cur)) return;
    f32x4 acc[2][2][4][2];
#pragma unroll
    for (int a = 0; a < 2; ++a)
#pragma unroll
        for (int b = 0; b < 2; ++b)
#pragma unroll
            for (int m = 0; m < 4; ++m)
#pragma unroll
                for (int n = 0; n < 2; ++n) acc[a][b][m][n] = (f32x4){0.f, 0.f, 0.f, 0.f};
    bf16x8 At[4][2], B0[2][2], B1[2][2];
    const char* cA = (const char*)g.A + (size_t)cur.pm * tstepA; const char* cB = (const char*)g.Bt + (size_t)cur.pn * tstepB;
    PG8_STAGE(PG8_SB(0, 0), cB, voffB); PG8_STAGE(PG8_SB(0, 1), cB + hstepB, voffB); PG8_STAGE(PG8_SA(0, 0), cA, voffA); PG8_STAGE(PG8_SA(0, 1), cA + hstepA, voffA);
    if (wr == 1) PG8_BAR;
    PG8_WAIT_V(2); PG8_BAR;
    PG8_STAGE(PG8_SB(1, 0), cB + kstep, voffB); PG8_STAGE(PG8_SA(1, 0), cA + kstep, voffA); PG8_STAGE(PG8_SB(1, 1), cB + hstepB + kstep, voffB);
    PG8_WAIT_V(6); PG8_BAR;
    for (;;) {
        const bool has_next = S.next(ui + 1, nxt);
        const char* nA = has_next ? (const char*)g.A + (size_t)nxt.pm * tstepA : cA; const char* nB = has_next ? (const char*)g.Bt + (size_t)nxt.pn * tstepB : cB;
        for (int t = 0; t < nt; t += 2) {
            const bool last = (t == nt - 2);
            const char* a1 = cA + (size_t)(t + 1) * kstep;
            const char* a2 = last ? nA : cA + (size_t)(t + 2) * kstep; const char* b2 = last ? nB : cB + (size_t)(t + 2) * kstep;
            const char* a3 = a2 + kstep; const char* b3 = b2 + kstep;
            PG8_LDB(B0, 0, 0); PG8_LDB(B1, 0, 1); PG8_SCHED; PG8_LDA(At, 0, 0); PG8_STAGE(PG8_SA(1, 1), a1 + hstepA, voffA);
            PG8_WAIT_V(8); PG8_WAIT_L(0); PG8_BAR; PG8_MMA(0, 0, At, B0); PG8_MMA(0, 1, At, B1); PG8_BAR; PG8_SCHED;
            PG8_LDA(At, 0, 1); PG8_STAGE(PG8_SB(0, 0), b2, voffB); PG8_STAGE(PG8_SB(0, 1), b2 + hstepB, voffB); PG8_STAGE(PG8_SA(0, 0), a2, voffA);
            PG8_WAIT_V(8); PG8_WAIT_L(0); PG8_BAR; PG8_MMA(1, 0, At, B0); PG8_MMA(1, 1, At, B1); PG8_BAR; PG8_SCHED;
            PG8_LDB(B0, 1, 0); PG8_LDB(B1, 1, 1); PG8_SCHED; PG8_LDA(At, 1, 0); PG8_STAGE(PG8_SA(0, 1), a2 + hstepA, voffA);
            PG8_WAIT_V(8); PG8_WAIT_L(0); PG8_BAR; PG8_MMA(0, 0, At, B0); PG8_MMA(0, 1, At, B1); PG8_BAR; PG8_SCHED;
            PG8_LDA(At, 1, 1); PG8_STAGE(PG8_SB(1, 0), b3, voffB); PG8_STAGE(PG8_SB(1, 1), b3 + hstepB, voffB); PG8_STAGE(PG8_SA(1, 0), a3, voffA);
            PG8_WAIT_V(8); PG8_WAIT_L(0); PG8_BAR; PG8_MMA(1, 0, At, B0); PG8_MMA(1, 1, At, B1); PG8_BAR; PG8_SCHED;
        }
        if (wr == 0) PG8_BAR;
        E(acc, cur, wr, wc, fr, fq);
        if (!has_next) break;
#pragma unroll
        for (int a = 0; a < 2; ++a)
#pragma unroll
            for (int b = 0; b < 2; ++b)
#pragma unroll
                for (int m = 0; m < 4; ++m)
#pragma unroll
                    for (int n = 0; n < 2; ++n) acc[a][b][m][n] = (f32x4){0.f, 0.f, 0.f, 0.f};
        cur = nxt; cA = nA; cB = nB; ++ui;
        if (wr == 1) PG8_BAR;
    }
    PG8_WAIT_V(0);
    PG8_BAR;
#undef PG8_SA
#undef PG8_SB
#undef PG8_STAGE
#undef PG8_LDA
#undef PG8_LDB
#undef PG8_MMA
#undef PG8_WAIT_V
#undef PG8_WAIT_L
#undef PG8_BAR
#undef PG8_SCHED
}
}

struct Args { const float* in[20]; float* out; unsigned char* ws; int ph_lo, ph_hi; };

struct Ctx {
    LAS unsigned char* lds; int tid, lane, wave, G, bid;
    const float* const* in; float* out; unsigned char* ws;
};
#define WSP(T_, off) ((T_*)(C.ws + (off)))

__device__ __forceinline__ int abmap(int n) { const int blk = n >> 9; return (int)((0x6514320u >> (4 * blk)) & 15u) * 512 + (n & 511); }
__device__ __forceinline__ void tr_item(const float* W, int K, int N, bf16_t* WT, const float* gain, int mapmode, LAS float* scr, int item, int lane) {
    const int nblk = (N + 31) / 32, kb = item / nblk, nb = item % nblk, k0 = 64 * kb, n0 = 32 * nb;
    const int nl = lane & 31, n = n0 + nl;
#pragma unroll 8
    for (int i = 0; i < 32; ++i) { const int kk = 2 * i + (lane >> 5); float v = 0.f;
        if (n < N) { v = W[(size_t)(k0 + kk) * N + n]; if (gain) v *= gain[k0 + kk]; }
        scr[kk * 33 + nl] = v; }
    LDS_WAIT();
    const int c = lane & 7;
#pragma unroll
    for (int j = 0; j < 4; ++j) { const int nn = (lane >> 3) + 8 * j, ns = n0 + nn;
        if (ns < N) { const int drow = mapmode ? abmap(ns) : ns; const LAS float* s = scr + (8 * c) * 33 + nn;
            u32x4 o; o.x = pk2(s[0 * 33], s[1 * 33]); o.y = pk2(s[2 * 33], s[3 * 33]); o.z = pk2(s[4 * 33], s[5 * 33]); o.w = pk2(s[6 * 33], s[7 * 33]);
            *(u32x4*)(WT + (size_t)drow * K + k0 + 8 * c) = o; } }
    LDS_WAIT();
}
__device__ __forceinline__ void conv_layer(const Ctx& C, int l) {
    LAS float* scr = (LAS float*)(C.lds + C.wave * 16384);
    bf16_t* WB = WSP(bf16_t, WS_W0 + (size_t)(l & 1) * WS_WSTRIDE);
    const int gw = C.bid * 8 + C.wave, NGW = C.G * 8;
    const bool even = (l & 1) == 0; const int sub = l >> 1;
    const int n_in = even ? AB_IN : C_IN;
    const int i0 = 16 * ((n_in + 31) / 32), i1 = 16 * 32, i2 = 16 * 32, i3 = 16 * 64, i4 = 16 * 32, i5 = 16 * 128, i6 = 64 * 32;
    const int tot = i0 + i1 + i2 + i3 + i4 + i5 + i6;
    for (int it = gw; it < tot; it += NGW) {
        int r = it;
        if (r < i0) { tr_item(even ? C.in[7] + (size_t)sub * D * AB_IN : C.in[12] + (size_t)sub * D * C_IN, D, n_in, WB + WO_IN, C.in[2] + l * D, even ? 1 : 0, scr, r, C.lane); continue; } r -= i0;
        if (r < i1) { tr_item(even ? C.in[11] + (size_t)sub * D * D : C.in[14] + (size_t)sub * D * D, D, D, WB + WO_OUT, nullptr, 0, scr, r, C.lane); continue; } r -= i1;
        if (r < i2) { tr_item(C.in[15] + (size_t)l * D * D, D, D, WB + WO_XQ, C.in[3] + l * D, 0, scr, r, C.lane); continue; } r -= i2;
        if (r < i3) { tr_item(C.in[16] + (size_t)l * D * 2 * D, D, 2 * D, WB + WO_XKV, C.in[4] + l * D, 0, scr, r, C.lane); continue; } r -= i3;
        if (r < i4) { tr_item(C.in[17] + (size_t)l * D * D, D, D, WB + WO_XO, nullptr, 0, scr, r, C.lane); continue; } r -= i4;
        if (r < i5) { tr_item(C.in[18] + (size_t)l * D * FF, D, FF, WB + WO_UP, C.in[5] + l * D, 0, scr, r, C.lane); continue; } r -= i5;
        tr_item(C.in[19] + (size_t)l * FF * D, FF, D, WB + WO_DOWN, nullptr, 0, scr, r, C.lane);
    }
}
__device__ __forceinline__ float row_to_bf16(const float* xrow, bf16_t* orow, int lane) {
    const f32x4* xr = (const f32x4*)xrow + lane; float s = 0.f;
    unsigned long long* o8 = (unsigned long long*)orow + lane;
#pragma unroll
    for (int j = 0; j < 4; ++j) { const f32x4 v = xr[64 * j]; s += (v[0] * v[0] + v[1] * v[1]) + (v[2] * v[2] + v[3] * v[3]);
        o8[64 * j] = (unsigned long long)pk2(v[0], v[1]) | ((unsigned long long)pk2(v[2], v[3]) << 32); }
    return wave_sum(s);
}
__device__ __forceinline__ void prologue(const Ctx& C) {
    conv_layer(C, 0);
    const int gw = C.bid * 8 + C.wave, NGW = C.G * 8;
    bf16_t* HB = WSP(bf16_t, WS_HB); float* RSS = WSP(float, WS_RSS);
    for (int m = gw; m < T; m += NGW) { const float ss = row_to_bf16(C.in[0] + (size_t)m * D, HB + (size_t)m * D, C.lane);
        if (C.lane < 16) RSS[(size_t)m * 16 + C.lane] = C.lane == 0 ? ss : 0.f; }
    bf16_t* MB = WSP(bf16_t, WS_MEMB); float* RM = WSP(float, WS_RSTDM);
    for (int m = gw; m < TM; m += NGW) { const float ss = row_to_bf16(C.in[1] + (size_t)m * D, MB + (size_t)m * D, C.lane);
        if (C.lane == 0) RM[m] = rsqrtf(ss * (1.0f / D) + EPS); }
}
__device__ __forceinline__ void final_norm(const Ctx& C) {
    const int gw = C.bid * 8 + C.wave, NGW = C.G * 8; const float* gn = C.in[6];
    for (int m = gw; m < T; m += NGW) { f32x4* xr = (f32x4*)(C.out + (size_t)m * D) + C.lane; f32x4 v[4]; float s = 0.f;
#pragma unroll
        for (int j = 0; j < 4; ++j) { v[j] = xr[64 * j]; s += (v[j][0] * v[j][0] + v[j][1] * v[j][1]) + (v[j][2] * v[j][2] + v[j][3] * v[j][3]); }
        const float rstd = rsqrtf(wave_sum(s) * (1.0f / D) + EPS);
#pragma unroll
        for (int j = 0; j < 4; ++j) { const f32x4 g4 = ((const f32x4*)gn)[C.lane + 64 * j]; xr[64 * j] = v[j] * rstd * g4; } }
}

__device__ __forceinline__ float log_sigmoid(float x) { return fminf(x, 0.f) - log1pf(__expf(-fabsf(x))); }
__device__ __forceinline__ float sigmoidf_(float x) { return 1.0f / (1.0f + __expf(-x)); }

template <int DH, int MODE>
__device__ __forceinline__ void naive_attn_row(const bf16_t* qrow, const bf16_t* Kb, const bf16_t* Vb, int ldkv, int nk, float scale,
                                               const float* tab, int rel0, const float* cum, int tpos, bf16_t* orow, LAS float* pl, LAS float* ql, int lane) {
#pragma unroll
    for (int j = 0; j < DH / 64; ++j) ql[lane + 64 * j] = bf2f(qrow[lane + 64 * j]);
    LDS_WAIT();
    float mx = -INFINITY;
    for (int k = lane; k < nk; k += 64) {
        const u32x4* kr = (const u32x4*)(Kb + (size_t)k * ldkv); float dot = 0.f;
#pragma unroll 4
        for (int c = 0; c < DH / 8; ++c) { const u32x4 w = kr[c];
#pragma unroll
            for (int e = 0; e < 4; ++e) { dot += ql[c * 8 + 2 * e] * __uint_as_float(w[e] << 16) + ql[c * 8 + 2 * e + 1] * __uint_as_float(w[e] & 0xffff0000u); } }
        float lg = dot * scale;
        if (MODE == 1) { int rel = rel0 - k; rel = rel < -128 ? -128 : (rel > 128 ? 128 : rel); lg += tab[rel + 128]; }
        if (MODE == 2) lg += cum[tpos] - cum[k];
        pl[k] = lg; mx = fmaxf(mx, lg);
    }
    mx = wave_max(mx); float sum = 0.f;
    for (int k = lane; k < nk; k += 64) { const float e = __expf(pl[k] - mx); pl[k] = e; sum += e; }
    sum = wave_sum(sum); LDS_WAIT();
    const float inv = 1.0f / sum;
#pragma unroll
    for (int j = 0; j < DH / 64; ++j) { const int d = lane + 64 * j; float a = 0.f;
        for (int k = 0; k < nk; ++k) a += pl[k] * bf2f(Vb[(size_t)k * ldkv + d]);
        orow[d] = (bf16_t)f2bf(a * inv); }
    LDS_WAIT();
}
__device__ __forceinline__ void naive_band(const Ctx& C, int e) {
    bf16_t* BIG = WSP(bf16_t, WS_BIG); const int gw = C.bid * 8 + C.wave, NGW = C.G * 8;
    LAS float* pl = (LAS float*)(C.lds + C.wave * 9216); LAS float* ql = pl + 2048;
    for (int it = gw; it < T * BH; it += NGW) { const int hd = it % BH, row = it / BH, b = row / SEQ, t = row % SEQ, cq = t / CHUNK;
        const int c0 = cq - 8 < 0 ? 0 : cq - 8, k0 = c0 * CHUNK, nk = (cq + 1) * CHUNK - k0;
        bf16_t* qp = BIG + (size_t)row * AB_IN + COL_QB + hd * BD;
        const bf16_t* kp = BIG + (size_t)(b * SEQ + k0) * AB_IN + COL_KB + hd * BD; const bf16_t* vp = BIG + (size_t)(b * SEQ + k0) * AB_IN + COL_VB + hd * BD;
        naive_attn_row<BD, 1>(qp, kp, vp, AB_IN, nk, 0.125f, C.in[10] + (size_t)(e * BH + hd) * 257, t - k0, nullptr, 0, qp, pl, ql, C.lane); }
}
__device__ __forceinline__ void naive_fox_cum(const Ctx& C, int o) {
    const bf16_t* BIG = WSP(bf16_t, WS_BIG); float* cum = WSP(float, WS_FOXC);
    const int g = C.bid * 512 + C.tid;
    if (g < NB * CH) { const int b = g / CH, hd = g % CH; const float fb = C.in[13][o * CH + hd]; float c = 0.f;
        for (int t = 0; t < SEQ; ++t) { c += log_sigmoid(bf2f(BIG[(size_t)(b * SEQ + t) * C_INP + COL_CF + hd]) + fb); cum[(size_t)g * SEQ + t] = c; } }
}
__device__ __forceinline__ void naive_fox(const Ctx& C) {
    bf16_t* BIG = WSP(bf16_t, WS_BIG); const float* cum = WSP(float, WS_FOXC); const int gw = C.bid * 8 + C.wave, NGW = C.G * 8;
    LAS float* pl = (LAS float*)(C.lds + C.wave * 9216); LAS float* ql = pl + 2048;
    for (int it = gw; it < T * CH; it += NGW) { const int hd = it % CH, row = it / CH, b = row / SEQ, t = row % SEQ;
        bf16_t* qp = BIG + (size_t)row * C_INP + COL_CQ + hd * CD;
        const bf16_t* kp = BIG + (size_t)(b * SEQ) * C_INP + COL_CK + hd * CD; const bf16_t* vp = BIG + (size_t)(b * SEQ) * C_INP + COL_CV + hd * CD;
        naive_attn_row<CD, 2>(qp, kp, vp, C_INP, t + 1, 0.125f, nullptr, 0, cum + (size_t)(b * CH + hd) * SEQ, t, qp, pl, ql, C.lane); }
}
__device__ __forceinline__ void naive_xattn(const Ctx& C) {
    bf16_t* XQ = WSP(bf16_t, WS_BIG); const bf16_t* KV = WSP(bf16_t, WS_MEMKV); const int gw = C.bid * 8 + C.wave, NGW = C.G * 8;
    LAS float* pl = (LAS float*)(C.lds + C.wave * 9216); LAS float* ql = pl + 2048;
    for (int it = gw; it < T * XH; it += NGW) { const int hd = it % XH, row = it / XH, b = row / SEQ;
        bf16_t* qp = XQ + (size_t)row * D + hd * XD;
        const bf16_t* kp = KV + (size_t)(b * MEMT) * 2 * D + hd * XD; const bf16_t* vp = kp + D;
        naive_attn_row<XD, 0>(qp, kp, vp, 2 * D, MEMT, 0.0625f, nullptr, 0, nullptr, 0, qp, pl, ql, C.lane); }
}
__device__ __forceinline__ void naive_hgrn(const Ctx& C, int e) {
    bf16_t* BIG = WSP(bf16_t, WS_BIG);
    LAS float* fL = (LAS float*)C.lds; LAS float* qL = fL + 2048; LAS float* vL = qL + 2048; LAS float* oL = vL + 2048;
    const int dv = C.tid & 127, kq = C.tid >> 7;
    for (int u = C.bid; u < NB * AH; u += C.G) { const int b = u / AH, hd = u % AH;
        float S[32];
#pragma unroll
        for (int i = 0; i < 32; ++i) S[i] = 0.f;
        for (int t0 = 0; t0 < SEQ; t0 += 16) {
            for (int idx = C.tid; idx < 2048; idx += 512) { const int r = idx >> 7, c = idx & 127; const size_t ro = (size_t)(b * SEQ + t0 + r) * AB_IN + hd * AD + c;
                float lb = 0.f; if (e == 1) { const float l0 = C.in[8][hd * AD + c], l1 = C.in[8][512 + hd * AD + c]; lb = 1.0f / (1.0f + __expf(l0 - l1)); }
                const float z = bf2f(BIG[ro + COL_FA]), q = bf2f(BIG[ro + COL_QA]);
                fL[idx] = lb + (1.0f - lb) * sigmoidf_(z); qL[idx] = q * sigmoidf_(q) * 0.08838834764831845f; vL[idx] = bf2f(BIG[ro + COL_IA]); }
            __syncthreads();
#pragma unroll 1
            for (int r = 0; r < 16; ++r) { const float v = vL[r * 128 + dv]; float po = 0.f;
#pragma unroll
                for (int i = 0; i < 32; ++i) { const float f = fL[r * 128 + kq * 32 + i]; S[i] = f * S[i] + (1.0f - f) * v; po += S[i] * qL[r * 128 + kq * 32 + i]; }
                oL[(r * 4 + kq) * 128 + dv] = po; }
            __syncthreads();
#pragma unroll
            for (int rr = 0; rr < 2; ++rr) { const int r = C.wave * 2 + rr; float o[2]; float ss = 0.f;
#pragma unroll
                for (int j = 0; j < 2; ++j) { const int d = C.lane + 64 * j; o[j] = (oL[(r * 4 + 0) * 128 + d] + oL[(r * 4 + 1) * 128 + d]) + (oL[(r * 4 + 2) * 128 + d] + oL[(r * 4 + 3) * 128 + d]); ss += o[j] * o[j]; }
                const float rstd = rsqrtf(wave_sum(ss) * (1.0f / AD) + EPS);
#pragma unroll
                for (int j = 0; j < 2; ++j) { const int d = C.lane + 64 * j; const size_t ro = (size_t)(b * SEQ + t0 + r) * AB_IN + hd * AD + d;
                    const float g = bf2f(BIG[ro + COL_GA]); const float val = o[j] * rstd * C.in[9][e * 512 + hd * AD + d] * (g * sigmoidf_(g));
                    BIG[ro + COL_QA] = (bf16_t)f2bf(val); } }
            __syncthreads();
        }
    }
}

typedef short v4i16_t __attribute__((ext_vector_type(4)));
__device__ __forceinline__ v4i16_t tr_read(const LAS unsigned char* p) { return __builtin_amdgcn_ds_read_tr16_b64_v4i16((LAS v4i16_t*)p); }
__device__ __forceinline__ unsigned cvtpk(float lo, float hi) { unsigned r; asm volatile("v_cvt_pk_bf16_f32 %0, %1, %2" : "=v"(r) : "v"(lo), "v"(hi)); return r; }
__device__ __forceinline__ int crow(int r, int hi) { return (r & 3) + 8 * (r >> 2) + 4 * hi; }

template <int DH, int MODE, int NSPLIT>
__device__ __forceinline__ void attn_unit(LAS unsigned char* lds, const bf16_t* Qp, int ldq, const bf16_t* Kp, const bf16_t* Vp, int ldkv, bf16_t* Op, int ldo,
                                          int kt0, int kt1, int tq0, float sc2, const LAS float* aux, int tid) {
    constexpr int KSTR = DH * 2 + 16, KB = 64 * KSTR, VB = 64 * DH * 2, CPR = DH / 8, NCH = DH / 64, ND0 = DH / 32 / NSPLIT, NS = DH / 16, NSUBD = DH / 32;
    const int lane = tid & 63, w = __builtin_amdgcn_readfirstlane(tid >> 6), hi = lane >> 5, l31 = lane & 31;
    const int qg = NSPLIT == 1 ? w : (w & 3), dsel = NSPLIT == 1 ? 0 : (w >> 2);
    const int qloc = qg * 32 + l31, tq = tq0 + qloc;
    bf16x8 qr[NS];
#pragma unroll
    for (int s = 0; s < NS; ++s) qr[s] = *(const bf16x8*)(Qp + (size_t)qloc * ldq + 16 * s + 8 * hi);
    f32x16 o[ND0];
#pragma unroll
    for (int i = 0; i < ND0; ++i)
#pragma unroll
        for (int r = 0; r < 16; ++r) o[i][r] = 0.f;
    float m = -1e30f, l = 0.f;
    const int qfirst = tq0 + qg * 32, cq = qfirst >> 6;
    float ct = 0.f; if (MODE == 2) ct = aux[tq];
    unsigned kso[NCH], vso[NCH]; size_t gso[NCH];
#pragma unroll
    for (int i = 0; i < NCH; ++i) { const int cidx = tid + 512 * i, row = cidx / CPR, ch = cidx % CPR;
        kso[i] = row * KSTR + ch * 16; vso[i] = ((row >> 3) * NSUBD + (ch >> 2)) * 512 + (row & 7) * 64 + (ch & 3) * 16; gso[i] = (size_t)row * ldkv + ch * 8; }
    const int vlane = (4 * hi + ((lane & 15) >> 2)) * 64 + ((lane >> 4) & 1) * 32 + (lane & 3) * 8;
    constexpr bool PREF = (DH == 64);
    u32x4 kreg[NCH], vreg[NCH];
    if (PREF) {
#pragma unroll
        for (int i = 0; i < NCH; ++i) { kreg[i] = *(const u32x4*)(Kp + (size_t)kt0 * 64 * ldkv + gso[i]); vreg[i] = *(const u32x4*)(Vp + (size_t)kt0 * 64 * ldkv + gso[i]); }
#pragma unroll
        for (int i = 0; i < NCH; ++i) { *(LAS u32x4*)(lds + kso[i]) = kreg[i]; *(LAS u32x4*)(lds + 2 * KB + vso[i]) = vreg[i]; }
    }
    __syncthreads();
    for (int t = kt0; t < kt1; ++t) {
        const int buf = PREF ? ((t - kt0) & 1) : 0;
        if (!PREF) {
#pragma unroll
            for (int i = 0; i < NCH; ++i) { const u32x4 kk = *(const u32x4*)(Kp + (size_t)t * 64 * ldkv + gso[i]); const u32x4 vv = *(const u32x4*)(Vp + (size_t)t * 64 * ldkv + gso[i]);
                *(LAS u32x4*)(lds + kso[i]) = kk; *(LAS u32x4*)(lds + 2 * KB + vso[i]) = vv; }
            __syncthreads();
        }
        if (PREF && t + 1 < kt1) {
#pragma unroll
            for (int i = 0; i < NCH; ++i) { kreg[i] = *(const u32x4*)(Kp + (size_t)(t + 1) * 64 * ldkv + gso[i]); vreg[i] = *(const u32x4*)(Vp + (size_t)(t + 1) * 64 * ldkv + gso[i]); }
        }
        bool active = true, masked = false;
        if (MODE == 1) active = (t >= cq - 8) && (t <= cq);
        if (MODE == 2) { active = (64 * t <= qfirst + 31); masked = (64 * t + 63 > qfirst); }
        if (active) {
            const LAS unsigned char* Kb = lds + buf * KB; const LAS unsigned char* Vb = lds + 2 * KB + buf * VB;
            f32x16 p0, p1;
#pragma unroll
            for (int r = 0; r < 16; ++r) { p0[r] = 0.f; p1[r] = 0.f; }
#pragma unroll
            for (int s = 0; s < NS; ++s) {
                const bf16x8 k0 = *(const LAS bf16x8*)(Kb + l31 * KSTR + (16 * s + 8 * hi) * 2);
                const bf16x8 k1 = *(const LAS bf16x8*)(Kb + (32 + l31) * KSTR + (16 * s + 8 * hi) * 2);
                p0 = __builtin_amdgcn_mfma_f32_32x32x16_bf16(k0, qr[s], p0, 0, 0, 0);
                p1 = __builtin_amdgcn_mfma_f32_32x32x16_bf16(k1, qr[s], p1, 0, 0, 0);
            }
            if (MODE == 0) {
#pragma unroll
                for (int r = 0; r < 16; ++r) { p0[r] *= sc2; p1[r] *= sc2; }
            } else if (MODE == 2) {
#pragma unroll
                for (int g = 0; g < 4; ++g) {
                    const f32x4 c0 = *(const LAS f32x4*)(aux + 64 * t + 8 * g + 4 * hi), c1 = *(const LAS f32x4*)(aux + 64 * t + 32 + 8 * g + 4 * hi);
#pragma unroll
                    for (int e = 0; e < 4; ++e) { p0[4 * g + e] = p0[4 * g + e] * sc2 + (ct - c0[e]); p1[4 * g + e] = p1[4 * g + e] * sc2 + (ct - c1[e]); }
                }
                if (masked) {
#pragma unroll
                    for (int r = 0; r < 16; ++r) { const int kv = 64 * t + crow(r, hi); if (kv > tq) p0[r] = -INFINITY; if (kv + 32 > tq) p1[r] = -INFINITY; }
                }
            } else {
                if (t <= cq - 3) { const float bc = aux[256];
#pragma unroll
                    for (int r = 0; r < 16; ++r) { p0[r] = p0[r] * sc2 + bc; p1[r] = p1[r] * sc2 + bc; }
                } else {
#pragma unroll
                    for (int r = 0; r < 16; ++r) { int rel = tq - (64 * t + crow(r, hi)); int i0 = rel > 128 ? 128 : rel, i1 = rel - 32 > 128 ? 128 : rel - 32; i0 = i0 < -128 ? -128 : i0; i1 = i1 < -128 ? -128 : i1;
                        p0[r] = p0[r] * sc2 + aux[i0 + 128]; p1[r] = p1[r] * sc2 + aux[i1 + 128]; }
                }
            }
            float mx = fmaxf(p0[0], p1[0]);
#pragma unroll
            for (int r = 1; r < 16; ++r) mx = fmaxf(mx, fmaxf(p0[r], p1[r]));
            mx = fmaxf(mx, __shfl_xor(mx, 32));
            const float mnew = fmaxf(m, mx), alpha = __builtin_amdgcn_exp2f(m - mnew);
            m = mnew; float ls = 0.f;
#pragma unroll
            for (int r = 0; r < 16; ++r) { p0[r] = __builtin_amdgcn_exp2f(p0[r] - mnew); p1[r] = __builtin_amdgcn_exp2f(p1[r] - mnew); ls += p0[r] + p1[r]; }
            l = l * alpha + ls;
#pragma unroll
            for (int i = 0; i < ND0; ++i)
#pragma unroll
                for (int r = 0; r < 16; ++r) o[i][r] *= alpha;
#pragma unroll
            for (int ks = 0; ks < 4; ++ks) {
                u32x4 pw;
                if (ks < 2) { pw.x = cvtpk(p0[8 * ks + 0], p0[8 * ks + 1]); pw.y = cvtpk(p0[8 * ks + 2], p0[8 * ks + 3]); pw.z = cvtpk(p0[8 * ks + 4], p0[8 * ks + 5]); pw.w = cvtpk(p0[8 * ks + 6], p0[8 * ks + 7]); }
                else { const int k2 = ks - 2; pw.x = cvtpk(p1[8 * k2 + 0], p1[8 * k2 + 1]); pw.y = cvtpk(p1[8 * k2 + 2], p1[8 * k2 + 3]); pw.z = cvtpk(p1[8 * k2 + 4], p1[8 * k2 + 5]); pw.w = cvtpk(p1[8 * k2 + 6], p1[8 * k2 + 7]); }
                const bf16x8 pf = __builtin_bit_cast(bf16x8, pw);
#pragma unroll
                for (int i = 0; i < ND0; ++i) { const int d0 = dsel * ND0 + i;
                    const v4i16_t lo = tr_read(Vb + ((2 * ks) * NSUBD + d0) * 512 + vlane), h4 = tr_read(Vb + ((2 * ks + 1) * NSUBD + d0) * 512 + vlane);
                    const bf16x8 vf = (bf16x8){lo[0], lo[1], lo[2], lo[3], h4[0], h4[1], h4[2], h4[3]};
                    o[i] = __builtin_amdgcn_mfma_f32_32x32x16_bf16(vf, pf, o[i], 0, 0, 0); }
            }
        }
        if (PREF && t + 1 < kt1) {
#pragma unroll
            for (int i = 0; i < NCH; ++i) { *(LAS u32x4*)(lds + (buf ^ 1) * KB + kso[i]) = kreg[i]; *(LAS u32x4*)(lds + 2 * KB + (buf ^ 1) * VB + vso[i]) = vreg[i]; }
        }
        __syncthreads();
    }
    l += __shfl_xor(l, 32);
    const float inv = 1.0f / l;
#pragma unroll
    for (int i = 0; i < ND0; ++i)
#pragma unroll
        for (int g = 0; g < 4; ++g) { u32x2 wv; wv.x = cvtpk(o[i][4 * g] * inv, o[i][4 * g + 1] * inv); wv.y = cvtpk(o[i][4 * g + 2] * inv, o[i][4 * g + 3] * inv);
            *(u32x2*)(Op + (size_t)qloc * ldo + (dsel * ND0 + i) * 32 + 8 * g + 4 * hi) = wv; }
}

constexpr int ATT64_AUX = 2 * 64 * 144 + 2 * 64 * 128;
__device__ __forceinline__ void fox_phase(const Ctx& C, int oidx, bool dry) {
    bf16_t* BIG = WSP(bf16_t, WS_BIG);
    LAS float* cl = (LAS float*)(C.lds + ATT64_AUX); LAS float* wtot = cl + SEQ;
    int cur_bh = -1;
    for (int u = C.bid; u < NB * CH * 8; u += C.G) { const int bh = u & 255, qb = u >> 8, b = bh >> 4, hd = bh & 15;
        if (bh != cur_bh) { cur_bh = bh;
            const float fb = C.in[13][oidx * CH + hd]; float s[4]; float run = 0.f;
#pragma unroll
            for (int j = 0; j < 4; ++j) { run += log_sigmoid(bf2f(BIG[(size_t)(b * SEQ + 4 * C.tid + j) * C_INP + COL_CF + hd]) + fb); s[j] = run; }
            float x = run;
#pragma unroll
            for (int off = 1; off < 64; off <<= 1) { const float n = __shfl_up(x, off); if (C.lane >= off) x += n; }
            __syncthreads();
            if (C.lane == 63) wtot[C.wave] = x;
            __syncthreads();
            float pre = 0.f;
            for (int ww = 0; ww < C.wave; ++ww) pre += wtot[ww];
            const float ex = x - run + pre;
#pragma unroll
            for (int j = 0; j < 4; ++j) cl[4 * C.tid + j] = (ex + s[j]) * LOG2E;
            __syncthreads();
        }
        bf16_t* qp = BIG + (size_t)(b * SEQ + qb * 256) * C_INP + COL_CQ + hd * CD;
        bf16_t* op = dry ? WSP(bf16_t, WS_HG) + (size_t)(b * SEQ + qb * 256) * 1024 + hd * CD : qp;
        attn_unit<64, 2, 1>(C.lds, qp, C_INP, BIG + (size_t)(b * SEQ) * C_INP + COL_CK + hd * CD, BIG + (size_t)(b * SEQ) * C_INP + COL_CV + hd * CD, C_INP, op, dry ? 1024 : C_INP,
                            0, 4 * qb + 4, qb * 256, 0.125f * LOG2E, cl, C.tid);
    }
}
__device__ __forceinline__ void band_phase(const Ctx& C, int e, bool dry) {
    bf16_t* BIG = WSP(bf16_t, WS_BIG);
    LAS float* tabL = (LAS float*)(C.lds + ATT64_AUX);
    for (int u = C.bid; u < NB * BH * 8; u += C.G) { const int i = u >> 8, v = u & 255, g = ((v & 7) + 2 * i) & 7, hd = (v >> 3) & 7, b = (v >> 6) + 4 * i;
        __syncthreads();
        if (C.tid < 257) tabL[C.tid] = C.in[10][(size_t)(e * BH + hd) * 257 + C.tid] * LOG2E;
        __syncthreads();
        bf16_t* qp = BIG + (size_t)(b * SEQ + g * 256) * AB_IN + COL_QB + hd * BD;
        bf16_t* op = dry ? BIG + (size_t)T * AB_IN + (size_t)(b * SEQ + g * 256) * 512 + hd * BD : qp;
        attn_unit<64, 1, 1>(C.lds, qp, AB_IN, BIG + (size_t)(b * SEQ) * AB_IN + COL_KB + hd * BD, BIG + (size_t)(b * SEQ) * AB_IN + COL_VB + hd * BD, AB_IN, op, dry ? 512 : AB_IN,
                            4 * g - 8 < 0 ? 0 : 4 * g - 8, 4 * g + 4, g * 256, 0.125f * LOG2E, tabL, C.tid);
    }
}
__device__ __forceinline__ void xattn_phase(const Ctx& C, bool dry) {
    bf16_t* XQ = WSP(bf16_t, WS_BIG); const bf16_t* KV = WSP(bf16_t, WS_MEMKV);
    for (int u = C.bid; u < NB * XH * 16; u += C.G) { const int qblk = u & 15, hd = (u >> 4) & 3, b = u >> 6;
        bf16_t* qp = XQ + (size_t)(b * SEQ + qblk * 128) * D + hd * XD;
        const bf16_t* kp = KV + (size_t)(b * MEMT) * 2 * D + hd * XD;
        bf16_t* op = dry ? qp + (size_t)T * D : qp;
        attn_unit<256, 0, 2>(C.lds, qp, D, kp, kp + D, 2 * D, op, D, 0, 4, 0, 0.0625f * LOG2E, nullptr, C.tid);
    }
}

constexpr int HG_QP = 0, HG_KP = 17408, HG_KE = 34816, HG_V = 51200, HG_GS = 67584;
__device__ __forceinline__ void hgrn_pass1(const Ctx& C, int e) {
    bf16_t* BIG = WSP(bf16_t, WS_BIG); bf16_t* HG = WSP(bf16_t, WS_HG); bf16_t* AM = WSP(bf16_t, WS_AMAT); float* DEC = WSP(float, WS_DEC);
    LAS unsigned char* L = C.lds; LAS float* gs = (LAS float*)(L + HG_GS);
    const int c = C.tid & 127, rg = C.tid >> 7, lane = C.lane, w = C.wave, hi = lane >> 5, l31 = lane & 31;
    const int vlane = (4 * hi + ((lane & 15) >> 2)) * 64 + ((lane >> 4) & 1) * 32 + (lane & 3) * 8;
    for (int item = C.bid; item < NB * AH * 32; item += C.G) { const int n = item & 31, hd = (item >> 5) & 3, b = item >> 7; const size_t tok0 = (size_t)b * SEQ + n * 64;
        float lb = 0.f; if (e == 1) { const float l0 = C.in[8][hd * AD + c], l1 = C.in[8][512 + hd * AD + c]; lb = 1.0f / (1.0f + __expf(l0 - l1)); }
        bf16_t* p = BIG + (tok0 + 16 * rg) * AB_IN + hd * AD + c;
        float bl[16], kk[16], qs[16]; float run = 0.f;
#pragma unroll
        for (int r = 0; r < 16; ++r) { const float z = bf2f(p[(size_t)r * AB_IN + COL_FA]), q = bf2f(p[(size_t)r * AB_IN + COL_QA]);
            const float sg = sigmoidf_(z), f = lb + (1.0f - lb) * sg; kk[r] = (1.0f - lb) * (1.0f - sg);
            run += (lb == 0.f) ? log_sigmoid(z) : __logf(f); bl[r] = run; qs[r] = q * sigmoidf_(q) * 0.08838834764831845f; }
        gs[rg * 128 + c] = run;
        __syncthreads();
        const float g0 = gs[c], g1 = gs[128 + c], g2 = gs[256 + c], g3 = gs[384 + c];
        const float base = rg == 0 ? 0.f : (rg == 1 ? g0 : (rg == 2 ? g0 + g1 : g0 + g1 + g2)), blast = (g0 + g1) + (g2 + g3), bmid = g0 + g1;
#pragma unroll
        for (int r = 0; r < 16; ++r) { const int row = 16 * rg + r; const float br = base + bl[r];
            float ep = br - bmid; ep = ep > 80.f ? 80.f : (ep < -80.f ? -80.f : ep);
            *(LAS bf16_t*)(L + HG_QP + row * 272 + c * 2) = (bf16_t)f2bf(qs[r] * __expf(ep));
            *(LAS bf16_t*)(L + HG_KP + row * 272 + c * 2) = (bf16_t)f2bf(kk[r] * __expf(-ep));
            const int so = ((row >> 3) * 4 + (c >> 5)) * 512 + (row & 7) * 64 + (c & 31) * 2;
            *(LAS bf16_t*)(L + HG_KE + so) = (bf16_t)f2bf(kk[r] * __expf(blast - br));
            *(LAS bf16_t*)(L + HG_V + so) = p[(size_t)r * AB_IN + COL_IA];
            p[(size_t)r * AB_IN + COL_QA] = (bf16_t)f2bf(qs[r] * __expf(br)); }
        if (rg == 0) DEC[(size_t)item * 128 + c] = __expf(blast);
        __syncthreads();
        if (w < 4) { const int tb = w >> 1, sb = w & 1; f32x16 acc;
#pragma unroll
            for (int r = 0; r < 16; ++r) acc[r] = 0.f;
#pragma unroll
            for (int s = 0; s < 8; ++s) { const bf16x8 qf = *(const LAS bf16x8*)(L + HG_QP + (32 * tb + l31) * 272 + (16 * s + 8 * hi) * 2);
                const bf16x8 kf = *(const LAS bf16x8*)(L + HG_KP + (32 * sb + l31) * 272 + (16 * s + 8 * hi) * 2);
                acc = __builtin_amdgcn_mfma_f32_32x32x16_bf16(qf, kf, acc, 0, 0, 0); }
            bf16_t* ao = AM + (size_t)item * 4096;
#pragma unroll
            for (int r = 0; r < 16; ++r) { const int t = 32 * tb + crow(r, hi), s2 = 32 * sb + l31; ao[t * 64 + s2] = (bf16_t)f2bf(s2 <= t ? acc[r] : 0.f); }
        }
#pragma unroll
        for (int jj = 0; jj < 2; ++jj) { const int j = 2 * w + jj, db = j >> 2, cb = j & 3; f32x16 acc;
#pragma unroll
            for (int r = 0; r < 16; ++r) acc[r] = 0.f;
#pragma unroll
            for (int ks = 0; ks < 4; ++ks) {
                const v4i16_t v0 = tr_read(L + HG_V + ((2 * ks) * 4 + db) * 512 + vlane), v1 = tr_read(L + HG_V + ((2 * ks + 1) * 4 + db) * 512 + vlane);
                const v4i16_t k0 = tr_read(L + HG_KE + ((2 * ks) * 4 + cb) * 512 + vlane), k1 = tr_read(L + HG_KE + ((2 * ks + 1) * 4 + cb) * 512 + vlane);
                const bf16x8 vf = (bf16x8){v0[0], v0[1], v0[2], v0[3], v1[0], v1[1], v1[2], v1[3]}, kf = (bf16x8){k0[0], k0[1], k0[2], k0[3], k1[0], k1[1], k1[2], k1[3]};
                acc = __builtin_amdgcn_mfma_f32_32x32x16_bf16(vf, kf, acc, 0, 0, 0); }
            bf16_t* ho = HG + (size_t)item * 16384;
#pragma unroll
            for (int r = 0; r < 16; ++r) ho[(32 * db + crow(r, hi)) * 128 + 32 * cb + l31] = (bf16_t)f2bf(acc[r]);
        }
        __syncthreads();
    }
}
__device__ __forceinline__ void hgrn_scan(const Ctx& C) {
    bf16_t* HG = WSP(bf16_t, WS_HG); const float* DEC = WSP(float, WS_DEC);
    for (int gid = C.bid * 512 + C.tid; gid < NB * AH * 2048; gid += C.G * 512) { const int bhd = gid >> 11, e8 = gid & 2047, dv = e8 >> 4, c8 = (e8 & 15) * 8;
        float st[8];
#pragma unroll
        for (int i = 0; i < 8; ++i) st[i] = 0.f;
#pragma unroll 4
        for (int n = 0; n < 32; ++n) { const size_t item = (size_t)bhd * 32 + n; u32x4* hp = (u32x4*)(HG + item * 16384 + dv * 128 + c8); const f32x4* dp = (const f32x4*)(DEC + item * 128 + c8);
            const u32x4 up = *hp; const f32x4 d0 = dp[0], d1 = dp[1];
            u32x4 o; o.x = pk2(st[0], st[1]); o.y = pk2(st[2], st[3]); o.z = pk2(st[4], st[5]); o.w = pk2(st[6], st[7]); *hp = o;
#pragma unroll
            for (int i = 0; i < 4; ++i) { const float ulo = __uint_as_float(up[i] << 16), uhi = __uint_as_float(up[i] & 0xffff0000u); const float da = i < 2 ? d0[2 * i] : d1[2 * i - 4], db2 = i < 2 ? d0[2 * i + 1] : d1[2 * i - 3];
                st[2 * i] = da * st[2 * i] + ulo; st[2 * i + 1] = db2 * st[2 * i + 1] + uhi; } }
    }
}
__device__ __forceinline__ void hgrn_pass3(const Ctx& C, int e) {
    bf16_t* BIG = WSP(bf16_t, WS_BIG); const bf16_t* HG = WSP(bf16_t, WS_HG); const bf16_t* AM = WSP(bf16_t, WS_AMAT);
    LAS unsigned char* L = C.lds; LAS float* ssum = (LAS float*)(L + 16384);
    const int lane = C.lane, w = C.wave, hi = lane >> 5, l31 = lane & 31, db = w >> 1, tb = w & 1;
    const int vlane = (4 * hi + ((lane & 15) >> 2)) * 64 + ((lane >> 4) & 1) * 32 + (lane & 3) * 8;
    for (int item = C.bid; item < NB * AH * 32; item += C.G) { const int n = item & 31, hd = (item >> 5) & 3, b = item >> 7; const size_t tok0 = (size_t)b * SEQ + n * 64;
#pragma unroll
        for (int i = 0; i < 2; ++i) { const int cidx = C.tid + 512 * i, row = cidx >> 4, ch = cidx & 15;
            *(LAS u32x4*)(L + ((row >> 3) * 4 + (ch >> 2)) * 512 + (row & 7) * 64 + (ch & 3) * 16) = *(const u32x4*)(BIG + (tok0 + row) * AB_IN + COL_IA + hd * AD + ch * 8); }
        __syncthreads();
        f32x16 acc;
#pragma unroll
        for (int r = 0; r < 16; ++r) acc[r] = 0.f;
        const bf16_t* sp = HG + (size_t)item * 16384 + (32 * db + l31) * 128 + 8 * hi;
        bf16_t* qrow = BIG + (tok0 + 32 * tb + l31) * AB_IN + hd * AD;
#pragma unroll
        for (int s = 0; s < 8; ++s) { const bf16x8 sf = *(const bf16x8*)(sp + 16 * s), qf = *(const bf16x8*)(qrow + COL_QA + 16 * s + 8 * hi);
            acc = __builtin_amdgcn_mfma_f32_32x32x16_bf16(sf, qf, acc, 0, 0, 0); }
        const bf16_t* ap = AM + (size_t)item * 4096 + (32 * tb + l31) * 64 + 4 * hi;
#pragma unroll
        for (int ks = 0; ks < 4; ++ks) {
            const v4i16_t v0 = tr_read(L + ((2 * ks) * 4 + db) * 512 + vlane), v1 = tr_read(L + ((2 * ks + 1) * 4 + db) * 512 + vlane);
            const bf16x8 vf = (bf16x8){v0[0], v0[1], v0[2], v0[3], v1[0], v1[1], v1[2], v1[3]};
            const u32x2 a0 = *(const u32x2*)(ap + 16 * ks), a1 = *(const u32x2*)(ap + 16 * ks + 8);
            const bf16x8 af = __builtin_bit_cast(bf16x8, (u32x4){a0.x, a0.y, a1.x, a1.y});
            acc = __builtin_amdgcn_mfma_f32_32x32x16_bf16(vf, af, acc, 0, 0, 0); }
        float ss = 0.f;
#pragma unroll
        for (int r = 0; r < 16; ++r) ss += acc[r] * acc[r];
        ss += __shfl_xor(ss, 32);
        if (hi == 0) ssum[db * 64 + 32 * tb + l31] = ss;
        __syncthreads();
        const int tl = 32 * tb + l31;
        const float rstd = rsqrtf(((ssum[tl] + ssum[64 + tl]) + (ssum[128 + tl] + ssum[192 + tl])) * (1.0f / AD) + EPS);
#pragma unroll
        for (int g = 0; g < 4; ++g) { const int dv0 = 32 * db + 8 * g + 4 * hi; const f32x4 gn = *(const f32x4*)(C.in[9] + e * 512 + hd * AD + dv0);
            const u32x2 gv = *(const u32x2*)(qrow + COL_GA + dv0);
            const float ga = __uint_as_float(gv.x << 16), gb = __uint_as_float(gv.x & 0xffff0000u), gc = __uint_as_float(gv.y << 16), gd = __uint_as_float(gv.y & 0xffff0000u);
            u32x2 o; o.x = cvtpk(acc[4 * g] * rstd * gn[0] * (ga * sigmoidf_(ga)), acc[4 * g + 1] * rstd * gn[1] * (gb * sigmoidf_(gb)));
            o.y = cvtpk(acc[4 * g + 2] * rstd * gn[2] * (gc * sigmoidf_(gc)), acc[4 * g + 3] * rstd * gn[3] * (gd * sigmoidf_(gd)));
            *(u32x2*)(qrow + COL_QA + dv0) = o; }
        __syncthreads();
    }
}

enum { K_PRO = 0, K_INPROJ = 1, K_MIXA = 2, K_MIXB = 3, K_MIXC = 4, K_OUTPROJ = 5, K_XQ = 6, K_XATTN = 7, K_XO = 8, K_UP = 9, K_DOWN = 10, K_FINAL = 11 };
constexpr unsigned long long EVEN_KINDS = 0xA987654321ull; constexpr int N_EVEN_PH = 10;
constexpr unsigned long long ODD_KINDS = 0xA9876531ull; constexpr int N_ODD_PH = 8;
constexpr int N_PHASES = 1 + 2 * (N_EVEN_PH + N_ODD_PH) + 1;

#ifndef PROBE_GEMM
#define PROBE_GEMM 1
#endif
#ifndef PROBE_SYNC
#define PROBE_SYNC 1
#endif
#ifndef PROBE_FOX
#define PROBE_FOX 0
#endif
#ifndef PROBE_BAND
#define PROBE_BAND 0
#endif
#ifndef PROBE_XATTN
#define PROBE_XATTN 0
#endif
#define GEMM_SCALE(MODE_, ACT_, M_, N_, K_, LDA_, A_, B_, O_, RS_) for (int rep_ = 0; rep_ < PROBE_GEMM; ++rep_) do { int t2_ = C.tid; asm volatile("" : "+v"(t2_)); pg8::Gemm g{A_, B_}; pg8::EpiScale<MODE_, ACT_, N_> E{O_, RS_}; pg8::StaticOrder S; S.init(M_, N_, C.G, C.bid); \
        pg8::gemm_phase<pg8::EpiScale<MODE_, ACT_, N_>, pg8::StaticOrder, K_, LDA_>(C.lds, g, S, E, t2_); } while (0)
#ifndef PROBE_XO
#define PROBE_XO 0
#endif
#define GEMM_RES(K_, LDA_, A_, B_, BASE_, NREP_) for (int rep_ = NREP_; rep_ >= 0; --rep_) do { int t2_ = C.tid; asm volatile("" : "+v"(t2_)); pg8::Gemm g{A_, B_}; \
        pg8::EpiRes E{BASE_, rep_ > 0 ? (float*)(BIG + (size_t)32 * 1024 * 1024) : C.out, rep_ > 0 ? BIG + (size_t)96 * 1024 * 1024 : HB, RSS}; pg8::StaticOrder S; S.init(T, D, C.G, C.bid); \
        pg8::gemm_phase<pg8::EpiRes, pg8::StaticOrder, K_, LDA_>(C.lds, g, S, E, t2_); } while (0)
#define XB_TMO      128
#define XB_XCNT(j)  (256  + 64 * (j))
#define XB_XSUB(j)  (1280 + 64 * (j))
#define XB_XGEN(j)  (2304 + 64 * (j))
#define XB_TOP      3328
#define XB_TOPGEN   3392
#define XCD_BAR_WORDS 3456
#define XB_SPIN_CAP (1u << 22)

__device__ __forceinline__ unsigned xb_ld(unsigned* p)              { return __hip_atomic_load(p, __ATOMIC_RELAXED, __HIP_MEMORY_SCOPE_AGENT); }
__device__ __forceinline__ unsigned xb_add(unsigned* p, unsigned v) { return __hip_atomic_fetch_add(p, v, __ATOMIC_RELAXED, __HIP_MEMORY_SCOPE_AGENT); }
__device__ __forceinline__ unsigned xb_xcc_id() { return (unsigned)__builtin_amdgcn_s_getreg((3 << 11) | 20) & 0xFu; }
#define XB_SPIN(cond, bar) do { unsigned _sp = 0; while (cond) { __builtin_amdgcn_s_sleep(1); \
    if ((++_sp & 255u) == 0u) { if (xb_ld(&(bar)[XB_TMO])) break; if (_sp > XB_SPIN_CAP) { atomicAdd(&(bar)[XB_TMO], 1u); break; } } } } while (0)

struct XcdBarrier {
    unsigned* bar; unsigned x;
    volatile LAS unsigned* st;
};

__device__ __forceinline__ XcdBarrier xcd_barrier_post(unsigned* bar, volatile LAS unsigned* st) {
    XcdBarrier b; b.bar = bar; b.x = xb_xcc_id(); b.st = st;
    if (threadIdx.x == 0) (void)xb_add(&bar[XB_XCNT(b.x)], 1u);
    return b;
}
__device__ __forceinline__ void xcd_barrier_complete(unsigned* bar, unsigned x, unsigned& nloc, unsigned& nx) {
    const unsigned G = gridDim.x * gridDim.y * gridDim.z;
    unsigned sum, cnt, mine, sp = 0u;
    for (;;) {
        sum = 0u; cnt = 0u; mine = 0u;
#pragma unroll
        for (unsigned j = 0; j < 16; ++j) { const unsigned c = xb_ld(&bar[XB_XCNT(j)]); sum += c; cnt += (c > 0u) ? 1u : 0u; mine = (j == x) ? c : mine; }
        if (sum == G) break;
        __builtin_amdgcn_s_sleep(1);
        if ((++sp & 255u) == 0u) { if (xb_ld(&bar[XB_TMO])) break; if (sp > XB_SPIN_CAP) { atomicAdd(&bar[XB_TMO], 1u); break; } }
    }
    nloc = mine > 0u ? mine : 1u; nx = cnt > 0u ? cnt : 1u;
}

__device__ __forceinline__ void xcd_barrier(const XcdBarrier& b) {
    asm volatile("s_waitcnt vmcnt(0)" ::: "memory");
    __syncthreads();
    if (threadIdx.x == 0) {
        unsigned* bar = b.bar;
        __builtin_amdgcn_s_waitcnt(0);
        unsigned nloc = b.st[0], nx = b.st[1];
        if (nloc == 0u) { xcd_barrier_complete(bar, b.x, nloc, nx); b.st[0] = nloc; b.st[1] = nx; }
        const unsigned old = xb_add(&bar[XB_XSUB(b.x)], 1u);
        const unsigned gen = old / nloc;
        if (old + 1u == (gen + 1u) * nloc) {
            __builtin_amdgcn_fence(__ATOMIC_RELEASE, "agent");
            asm volatile("s_waitcnt vmcnt(0)" ::: "memory");
            const unsigned og = xb_add(&bar[XB_TOP], 1u);
            const unsigned tg = og / nx;
            if (og + 1u == (tg + 1u) * nx) xb_add(&bar[XB_TOPGEN], 1u);
            else XB_SPIN(xb_ld(&bar[XB_TOPGEN]) == tg, bar);
            __builtin_amdgcn_fence(__ATOMIC_ACQUIRE, "agent");
            xb_add(&bar[XB_XGEN(b.x)], 1u);
            asm volatile("s_waitcnt vmcnt(0)" ::: "memory");
        } else {
            XB_SPIN(xb_ld(&bar[XB_XGEN(b.x)]) == gen, bar);
            __builtin_amdgcn_fence(__ATOMIC_ACQUIRE, "agent");
            asm volatile("s_waitcnt vmcnt(0)" ::: "memory");
        }
    }
    __syncthreads();
}

__global__ void __launch_bounds__(512, 2) mega(Args a) {
    extern __shared__ __attribute__((aligned(16))) unsigned char lds_raw[];
    Ctx C; C.lds = (LAS unsigned char*)lds_raw; C.tid = threadIdx.x; C.lane = C.tid & 63; C.wave = __builtin_amdgcn_readfirstlane(C.tid >> 6); C.G = gridDim.x; C.bid = blockIdx.x;
    C.in = a.in; C.out = a.out; C.ws = a.ws;
    cg::grid_group grid = cg::this_grid();
    volatile LAS unsigned* MISC = (volatile LAS unsigned*)(C.lds + LDS_BYTES - 64);
    if (threadIdx.x < 16) MISC[threadIdx.x] = 0u;
    __syncthreads();
    const XcdBarrier bar = xcd_barrier_post((unsigned*)a.ws, MISC);
    for (int ph = a.ph_lo; ph < a.ph_hi; ++ph) {
        { int t_ = threadIdx.x; asm volatile("" : "+v"(t_)); C.tid = t_; C.lane = t_ & 63; C.wave = __builtin_amdgcn_readfirstlane(t_ >> 6); }
        int l = 0, kind;
        if (ph == 0) kind = K_PRO; else if (ph == N_PHASES - 1) kind = K_FINAL;
        else { const int r = ph - 1, pair = r / (N_EVEN_PH + N_ODD_PH), rr = r % (N_EVEN_PH + N_ODD_PH);
            if (rr < N_EVEN_PH) { l = 2 * pair; kind = (int)((EVEN_KINDS >> (4 * rr)) & 15ull); } else { l = 2 * pair + 1; kind = (int)((ODD_KINDS >> (4 * (rr - N_EVEN_PH))) & 15ull); } }
        const bool even = (l & 1) == 0;
        bf16_t* WB = WSP(bf16_t, WS_W0 + (size_t)(l & 1) * WS_WSTRIDE);
        bf16_t* HB = WSP(bf16_t, WS_HB); bf16_t* BIG = WSP(bf16_t, WS_BIG); float* RSS = WSP(float, WS_RSS);
        if (kind == K_PRO) prologue(C);
        else if (kind == K_FINAL) final_norm(C);
        else if (kind == K_INPROJ) {
            if (even) GEMM_SCALE(0, 0, T, AB_IN, D, D, HB, WB + WO_IN, BIG, RSS); else GEMM_SCALE(0, 0, T, C_INP, D, D, HB, WB + WO_IN, BIG, RSS);
        } else if (kind == K_XQ) {
            GEMM_SCALE(0, 0, T, D, D, D, HB, WB + WO_XQ, BIG, RSS);
            GEMM_SCALE(1, 0, TM, 2 * D, D, D, WSP(bf16_t, WS_MEMB), WB + WO_XKV, WSP(bf16_t, WS_MEMKV), WSP(float, WS_RSTDM));
        } else if (kind == K_UP) {
            GEMM_SCALE(0, 1, T, FF, D, D, HB, WB + WO_UP, BIG, RSS);
        } else if (kind == K_OUTPROJ) {
            const float* base = l == 0 ? C.in[0] : C.out;
            if (even) GEMM_RES(D, AB_IN, BIG, WB + WO_OUT, base, 0); else GEMM_RES(D, C_INP, BIG, WB + WO_OUT, base, 0);
        } else if (kind == K_XO) {
            GEMM_RES(D, D, BIG, WB + WO_XO, C.out, PROBE_XO);
        } else if (kind == K_DOWN) {
            GEMM_RES(FF, FF, BIG, WB + WO_DOWN, C.out, 0);
        } else if (kind == K_MIXA) {
            if (even) { hgrn_pass1(C, l >> 1); for (int rep_ = PROBE_BAND; rep_ >= 0; --rep_) { { int t_ = threadIdx.x; asm volatile("" : "+v"(t_)); C.tid = t_; C.lane = t_ & 63; C.wave = __builtin_amdgcn_readfirstlane(t_ >> 6); } band_phase(C, l >> 1, rep_ > 0); } }
        } else if (kind == K_MIXB) {
            if (even) hgrn_scan(C); else for (int rep_ = PROBE_FOX; rep_ >= 0; --rep_) { { int t_ = threadIdx.x; asm volatile("" : "+v"(t_)); C.tid = t_; C.lane = t_ & 63; C.wave = __builtin_amdgcn_readfirstlane(t_ >> 6); } fox_phase(C, l >> 1, rep_ > 0); }
        } else if (kind == K_MIXC) {
            hgrn_pass3(C, l >> 1);
        } else if (kind == K_XATTN) {
            for (int rep_ = PROBE_XATTN; rep_ >= 0; --rep_) { { int t_ = threadIdx.x; asm volatile("" : "+v"(t_)); C.tid = t_; C.lane = t_ & 63; C.wave = __builtin_amdgcn_readfirstlane(t_ >> 6); } xattn_phase(C, rep_ > 0); }
            __syncthreads();
            if (l + 1 < DEPTH) conv_layer(C, l + 1);
        }
        if (ph + 1 < a.ph_hi) for (int rep_ = 0; rep_ < PROBE_SYNC; ++rep_) { if (ph == 0) grid.sync(); else xcd_barrier(bar); }
    }
}

#ifndef SINGLE_LAUNCH
#define SINGLE_LAUNCH 1
#endif
extern "C" void kernel_launch(void* const* d_in, const int* in_sizes, int n_in, void* d_out, int out_size, void* d_ws, size_t ws_size, hipStream_t stream) {
    static int grid = 0;
    if (grid == 0) {
        if (n_in != 20 || out_size != T * D || ws_size < WS_END) { fprintf(stderr, "kernel_launch: unexpected shapes (n_in %d out %d ws %zu)\n", n_in, out_size, ws_size); grid = -1; return; }
        int dev = 0, cus = 0, per_cu = 0;
        hipGetDevice(&dev); hipDeviceGetAttribute(&cus, hipDeviceAttributeMultiprocessorCount, dev);
        if (hipFuncSetAttribute((const void*)mega, hipFuncAttributeMaxDynamicSharedMemorySize, LDS_BYTES) != hipSuccess) { fprintf(stderr, "kernel_launch: hipFuncSetAttribute failed\n"); grid = -1; return; }
        if (hipOccupancyMaxActiveBlocksPerMultiprocessor(&per_cu, (const void*)mega, 512, LDS_BYTES) != hipSuccess || per_cu < 1) { fprintf(stderr, "kernel_launch: occupancy query says %d\n", per_cu); per_cu = 1; }
        (void)hipGetLastError();
        grid = cus * 1;
    }
    if (grid < 0) return;
    Args a{};
    for (int i = 0; i < 20; ++i) a.in[i] = (const float*)d_in[i];
    a.out = (float*)d_out; a.ws = (unsigned char*)d_ws;
    if (hipMemsetAsync(d_ws, 0, 16384, stream) != hipSuccess) { fprintf(stderr, "kernel_launch: memset failed\n"); return; }
#if SINGLE_LAUNCH
    a.ph_lo = 0; a.ph_hi = N_PHASES;
    void* args[] = {&a};
    hipError_t e = hipLaunchCooperativeKernel((const void*)mega, dim3(grid), dim3(512), args, LDS_BYTES, stream);
    if (e != hipSuccess) fprintf(stderr, "cooperative launch failed: %s (grid %d)\n", hipGetErrorString(e), grid);
#else
    for (int ph = 0; ph < N_PHASES; ++ph) { a.ph_lo = ph; a.ph_hi = ph + 1; hipLaunchKernelGGL(mega, dim3(grid), dim3(512), LDS_BYTES, stream, a); }
#endif
}
```

```cpp
#include <hip/hip_runtime.h>
#include <hip/hip_cooperative_groups.h>
#include <cstdio>
#include <cstdint>
namespace cg = cooperative_groups;

#define LAS __attribute__((address_space(3)))
typedef unsigned short bf16_t;
typedef short bf16x8 __attribute__((ext_vector_type(8)));
typedef float f32x4 __attribute__((ext_vector_type(4)));
typedef float f32x16 __attribute__((ext_vector_type(16)));
typedef unsigned u32x4 __attribute__((ext_vector_type(4)));
typedef unsigned u32x2 __attribute__((ext_vector_type(2)));

constexpr int D = 1024, NB = 16, SEQ = 2048, T = NB * SEQ, DEPTH = 4, CHUNK = 64, MEMT = 256, TM = NB * MEMT;
constexpr int AH = 4, AD = 128, BH = 8, BD = 64, AB_IN = 3584, CH = 16, CD = 64, C_IN = 3088, C_INP = 3328, XH = 4, XD = 256, FF = 4096;
constexpr float EPS = 1e-6f;
constexpr float LOG2E = 1.4426950408889634f;
constexpr int COL_QA = 0, COL_QB = 512, COL_FA = 1024, COL_IA = 1536, COL_GA = 2048, COL_KB = 2560, COL_VB = 3072;
constexpr int COL_CQ = 0, COL_CK = 1024, COL_CV = 2048, COL_CF = 3072;

constexpr size_t MiB = 1ull << 20;
constexpr size_t WS_RSS = 1 * MiB, WS_RSTDM = 3 * MiB, WS_FOXC = 4 * MiB, WS_DEC = 6 * MiB, WS_MEMB = 8 * MiB, WS_MEMKV = 16 * MiB;
constexpr size_t WS_W0 = 32 * MiB, WS_WSTRIDE = 33 * MiB, WS_HB = 98 * MiB, WS_BIG = 162 * MiB, WS_HG = 418 * MiB, WS_AMAT = 482 * MiB, WS_END = 498 * MiB;
constexpr size_t WO_IN = 0, WO_OUT = (size_t)3584 * 1024, WO_XQ = WO_OUT + 1024 * 1024, WO_XKV = WO_XQ + 1024 * 1024, WO_XO = WO_XKV + 2048 * 1024,
                 WO_UP = WO_XO + 1024 * 1024, WO_DOWN = WO_UP + (size_t)4096 * 1024;
static_assert((WO_DOWN + (size_t)4096 * 1024) * 2 <= WS_WSTRIDE, "weight buffer");

constexpr int LDS_BYTES = 147456;

__device__ __forceinline__ float bf2f(bf16_t v) { return __uint_as_float(((unsigned)v) << 16); }
__device__ __forceinline__ unsigned f2bf(float f) { unsigned u = __float_as_uint(f); return (u + 0x7fffu + ((u >> 16) & 1u)) >> 16; }
__device__ __forceinline__ unsigned pk2(float lo, float hi) { return f2bf(lo) | (f2bf(hi) << 16); }
__device__ __forceinline__ float wave_sum(float v) {
#pragma unroll
    for (int o = 1; o < 64; o <<= 1) v += __shfl_xor(v, o);
    return v;
}
__device__ __forceinline__ float wave_max(float v) {
#pragma unroll
    for (int o = 1; o < 64; o <<= 1) v = fmaxf(v, __shfl_xor(v, o));
    return v;
}
#define LDS_WAIT() asm volatile("s_waitcnt lgkmcnt(0)" ::: "memory")

namespace pg8 {
constexpr int BM = 256, BK = 64, HALF = 128, HTB = HALF * BK * 2, STAGE_BYTES = 8 * HTB, NXCD = 8, WGM = 8;
__host__ __device__ __forceinline__ int lds_byte(int r, int c) { const int st = (r >> 4) * 2 + (c >> 5), rr = r & 15, cc = c & 31, ob = rr * 64 + cc * 2; return st * 1024 + (ob ^ (((ob >> 9) & 1) << 5)); }
__host__ __device__ __forceinline__ void stage_rc(int b, int& R, int& C) { const int st = b / 1024, sb = b % 1024, swz = sb ^ (((sb >> 9) & 1) << 5); R = (st >> 1) * 16 + swz / 64; C = (st & 1) * 32 + (swz % 64) / 2; }
__host__ __device__ __forceinline__ int perm32(int rho) { const int n = rho >> 4, i = rho & 15; return 8 * (i >> 2) + 4 * n + (i & 3); }

struct Unit { int pm, pn; };
struct Gemm { const bf16_t* A; const bf16_t* Bt; };

struct StaticOrder {
    int nM, nN, nwg, G, c;
    __host__ __device__ void init(int M, int N, int G_, int c_) { nM = M / BM; nN = N / BM; nwg = nM * nN; G = G_; c = c_; }
    __host__ __device__ bool next(int i, Unit& u) const {
        const long L = (long)i * G + c; if (L >= nwg) return false;
        int wgid = (int)L; { const int q = nwg / NXCD, r = nwg % NXCD, xcd = wgid % NXCD, off = wgid / NXCD; wgid = (xcd < r ? xcd * (q + 1) : r * (q + 1) + (xcd - r) * q) + off; }
        const int nig = WGM * nN, gid = wgid / nig, fm = gid * WGM, gsz = (nM - fm) < WGM ? (nM - fm) : WGM;
        u.pm = fm + ((wgid % nig) % gsz); u.pn = (wgid % nig) / gsz; return true;
    }
};
__device__ __forceinline__ unsigned cvt_pk_bf16(float lo, float hi) { unsigned r; asm volatile("v_cvt_pk_bf16_f32 %0, %1, %2" : "=v"(r) : "v"(lo), "v"(hi)); return r; }

template <int mode, int act, int ldc> struct EpiScale {
    static constexpr bool PERM = true;
    bf16_t* O; const float* rs;
    __device__ __forceinline__ void operator()(const f32x4 (&acc)[2][2][4][2], const Unit& u, int wr, int wc, int fr, int fq) const {
        const int row0 = u.pm * BM + wr * 64 + fr, col0 = u.pn * BM + wc * 32 + 8 * fq;
        float rstd[8];
        if (mode == 0) {
            f32x4 pr[8];
#pragma unroll
            for (int i = 0; i < 8; ++i) pr[i] = *(const f32x4*)(rs + (size_t)(row0 + (i >> 2) * HALF + (i & 3) * 16) * 16 + 4 * fq);
#pragma unroll
            for (int i = 0; i < 8; ++i) { float ss = (pr[i][0] + pr[i][1]) + (pr[i][2] + pr[i][3]); ss += __shfl_xor(ss, 16); ss += __shfl_xor(ss, 32);
                rstd[i] = rsqrtf(ss * (1.0f / D) + EPS); }
        } else {
#pragma unroll
            for (int i = 0; i < 8; ++i) rstd[i] = rs[row0 + (i >> 2) * HALF + (i & 3) * 16];
        }
#pragma unroll
        for (int ai = 0; ai < 2; ++ai)
#pragma unroll
            for (int m = 0; m < 4; ++m) {
                const int row = row0 + ai * HALF + m * 16; const float rsd = rstd[ai * 4 + m];
                bf16_t* rowp = O + (size_t)row * ldc + col0;
#pragma unroll
                for (int bj = 0; bj < 2; ++bj) { f32x4 v0 = acc[ai][bj][m][0] * rsd, v1 = acc[ai][bj][m][1] * rsd;
                    if (act) {
#pragma unroll
                        for (int e = 0; e < 4; ++e) { const float a0 = fmaxf(v0[e], 0.f), a1 = fmaxf(v1[e], 0.f); v0[e] = a0 * a0; v1[e] = a1 * a1; } }
                    u32x4 w; w.x = cvt_pk_bf16(v0[0], v0[1]); w.y = cvt_pk_bf16(v0[2], v0[3]); w.z = cvt_pk_bf16(v1[0], v1[1]); w.w = cvt_pk_bf16(v1[2], v1[3]);
                    *(u32x4*)(rowp + bj * HALF) = w; }
            }
    }
};
struct EpiRes {
    static constexpr bool PERM = false;
    bf16_t* hb; float* rss;
    __device__ __forceinline__ void operator()(const f32x4 (&acc)[2][2][4][2], const Unit& u, int wr, int wc, int fr, int fq) const {
        const int row0 = u.pm * BM + wr * 64 + fr, col0 = u.pn * BM + wc * 32 + 4 * fq;
#pragma unroll
        for (int ai = 0; ai < 2; ++ai) {
            u32x2 bv[4][2][2];
#pragma unroll
            for (int m = 0; m < 4; ++m)
#pragma unroll
                for (int bj = 0; bj < 2; ++bj)
#pragma unroll
                    for (int n = 0; n < 2; ++n) bv[m][bj][n] = *(const u32x2*)(hb + (size_t)(row0 + ai * HALF + m * 16) * D + col0 + bj * HALF + n * 16);
            asm volatile("" ::: "memory");
#pragma unroll
            for (int m = 0; m < 4; ++m) {
                const int row = row0 + ai * HALF + m * 16; const size_t off = (size_t)row * D + col0; float ss = 0.f;
#pragma unroll
                for (int bj = 0; bj < 2; ++bj)
#pragma unroll
                    for (int n = 0; n < 2; ++n) { const size_t o2 = off + bj * HALF + n * 16; const u32x2 b = bv[m][bj][n]; const f32x4 a = acc[ai][bj][m][n];
                        const float o0 = __uint_as_float(b.x << 16) + a[0], o1 = __uint_as_float(b.x & 0xffff0000u) + a[1], o2f = __uint_as_float(b.y << 16) + a[2], o3 = __uint_as_float(b.y & 0xffff0000u) + a[3];
                        ss += (o0 * o0 + o1 * o1) + (o2f * o2f + o3 * o3);
                        u32x2 w; w.x = cvt_pk_bf16(o0, o1); w.y = cvt_pk_bf16(o2f, o3); *(u32x2*)(hb + o2) = w; }
                ss += __shfl_xor(ss, 16); ss += __shfl_xor(ss, 32);
                if (fq == 0) rss[(size_t)row * 16 + u.pn * 4 + wc] = ss;
            }
            asm volatile("" ::: "memory");
        }
    }
};

template <class Epi, class Sched, int K, int lda>
__device__ __forceinline__ void gemm_phase(LAS unsigned char* lds, const Gemm g, const Sched& S, const Epi& E, const int tid) {
    const int wid = __builtin_amdgcn_readfirstlane(tid >> 6), lane = tid & 63, wr = wid >> 2, wc = wid & 3, fr = lane & 15, fq = lane >> 4;
    constexpr int nt = K / BK;
    unsigned voffA[2], voffB[2];
#pragma unroll
    for (int i = 0; i < 2; ++i) { int R, C; stage_rc(tid * 16 + i * 8192, R, C); const int Rb = Epi::PERM ? ((R & ~31) + perm32(R & 31)) : R;
        voffA[i] = (unsigned)(R * lda + C) * 2u; voffB[i] = (unsigned)(Rb * K + C) * 2u; }
    const size_t kstep = (size_t)(BK * 2);
    const size_t hstepA = (size_t)HALF * lda * 2, hstepB = (size_t)HALF * K * 2;
    const size_t tstepA = 2 * hstepA, tstepB = 2 * hstepB;
    const unsigned ldsw = (unsigned)wid * 1024u;
    const int aoff = lds_byte(wr * 64 + fr, fq * 8), boff = lds_byte(wc * 32 + fr, fq * 8);
#define PG8_SA(b, h) (((b) * 2 + (h)) * HTB)
#define PG8_SB(b, h) ((4 + (b) * 2 + (h)) * HTB)
#define PG8_STAGE(bufoff, gbase, voff) do { _Pragma("unroll") for (int _i = 0; _i < 2; ++_i) \
        __builtin_amdgcn_global_load_lds((const unsigned*)((const char*)(gbase) + (voff)[_i]), (LAS unsigned*)(lds + (bufoff) + ldsw + _i * 8192), 16, 0, 0); } while (0)
#define PG8_LDA(dst, b, h) do { _Pragma("unroll") for (int m = 0; m < 4; ++m) _Pragma("unroll") for (int k = 0; k < 2; ++k) dst[m][k] = *(const LAS bf16x8*)(lds + PG8_SA(b, h) + aoff + m * 2048 + k * 1024); } while (0)
#define PG8_LDB(dst, b, h) do { _Pragma("unroll") for (int n = 0; n < 2; ++n) _Pragma("unroll") for (int k = 0; k < 2; ++k) dst[n][k] = *(const LAS bf16x8*)(lds + PG8_SB(b, h) + boff + n * 2048 + k * 1024); } while (0)
#define PG8_MMA(ai, bj, At, Bt) do { __builtin_amdgcn_s_setprio(1); _Pragma("unroll") for (int m = 0; m < 4; ++m) _Pragma("unroll") for (int n = 0; n < 2; ++n) _Pragma("unroll") for (int k = 0; k < 2; ++k) \
        acc[ai][bj][m][n] = __builtin_amdgcn_mfma_f32_16x16x32_bf16(Bt[n][k], At[m][k], acc[ai][bj][m][n], 0, 0, 0); __builtin_amdgcn_s_setprio(0); } while (0)
#define PG8_WAIT_V(n) asm volatile("s_waitcnt vmcnt(" #n ")" ::: "memory")
#define PG8_WAIT_L(n) asm volatile("s_waitcnt lgkmcnt(" #n ")" ::: "memory")
#define PG8_BAR __builtin_amdgcn_s_barrier()
#define PG8_SCHED __builtin_amdgcn_sched_barrier(0)
    Unit cur, nxt; int ui = 0;
    if (!S.next(0, cur)) return;
    f32x4 acc[2][2][4][2];
#pragma unroll
    for (int a = 0; a < 2; ++a)
#pragma unroll
        for (int b = 0; b < 2; ++b)
#pragma unroll
            for (int m = 0; m < 4; ++m)
#pragma unroll
                for (int n = 0; n < 2; ++n) acc[a][b][m][n] = (f32x4){0.f, 0.f, 0.f, 0.f};
    bf16x8 At[4][2], B0[2][2], B1[2][2];
    const char* cA = (const char*)g.A + (size_t)cur.pm * tstepA; const char* cB = (const char*)g.Bt + (size_t)cur.pn * tstepB;
    PG8_STAGE(PG8_SB(0, 0), cB, voffB); PG8_STAGE(PG8_SB(0, 1), cB + hstepB, voffB); PG8_STAGE(PG8_SA(0, 0), cA, voffA); PG8_STAGE(PG8_SA(0, 1), cA + hstepA, voffA);
    if (wr == 1) PG8_BAR;
    PG8_WAIT_V(2); PG8_BAR;
    PG8_STAGE(PG8_SB(1, 0), cB + kstep, voffB); PG8_STAGE(PG8_SA(1, 0), cA + kstep, voffA); PG8_STAGE(PG8_SB(1, 1), cB + hstepB + kstep, voffB);
    PG8_WAIT_V(6); PG8_BAR;
    for (;;) {
        const bool has_next = S.next(ui + 1, nxt);
        const char* nA = has_next ? (const char*)g.A + (size_t)nxt.pm * tstepA : cA; const char* nB = has_next ? (const char*)g.Bt + (size_t)nxt.pn * tstepB : cB;
        for (int t = 0; t < nt; t += 2) {
            const bool last = (t == nt - 2);
            const char* a1 = cA + (size_t)(t + 1) * kstep;
            const char* a2 = last ? nA : cA + (size_t)(t + 2) * kstep; const char* b2 = last ? nB : cB + (size_t)(t + 2) * kstep;
            const char* a3 = a2 + kstep; const char* b3 = b2 + kstep;
            PG8_LDB(B0, 0, 0); PG8_LDB(B1, 0, 1); PG8_SCHED; PG8_LDA(At, 0, 0); PG8_STAGE(PG8_SA(1, 1), a1 + hstepA, voffA);
            PG8_WAIT_V(8); PG8_WAIT_L(0); PG8_BAR; PG8_MMA(0, 0, At, B0); PG8_MMA(0, 1, At, B1); PG8_BAR; PG8_SCHED;
            PG8_LDA(At, 0, 1); PG8_STAGE(PG8_SB(0, 0), b2, voffB); PG8_STAGE(PG8_SB(0, 1), b2 + hstepB, voffB); PG8_STAGE(PG8_SA(0, 0), a2, voffA);
            PG8_WAIT_V(8); PG8_WAIT_L(0); PG8_BAR; PG8_MMA(1, 0, At, B0); PG8_MMA(1, 1, At, B1); PG8_BAR; PG8_SCHED;
            PG8_LDB(B0, 1, 0); PG8_LDB(B1, 1, 1); PG8_SCHED; PG8_LDA(At, 1, 0); PG8_STAGE(PG8_SA(0, 1), a2 + hstepA, voffA);
            PG8_WAIT_V(8); PG8_WAIT_L(0); PG8_BAR; PG8_MMA(0, 0, At, B0); PG8_MMA(0, 1, At, B1); PG8_BAR; PG8_SCHED;
            PG8_LDA(At, 1, 1); PG8_STAGE(PG8_SB(1, 0), b3, voffB); PG8_STAGE(PG8_SB(1, 1), b3 + hstepB, voffB); PG8_STAGE(PG8_SA(1, 0), a3, voffA);
            PG8_WAIT_V(8); PG8_WAIT_L(0); PG8_BAR; PG8_MMA(1, 0, At, B0); PG8_MMA(1, 1, At, B1); PG8_BAR; PG8_SCHED;
        }
        if (wr == 0) PG8_BAR;
        E(acc, cur, wr, wc, fr, fq);
        if (!has_next) break;
#pragma unroll
        for (int a = 0; a < 2; ++a)
#pragma unroll
            for (int b = 0; b < 2; ++b)
#pragma unroll
                for (int m = 0; m < 4; ++m)
#pragma unroll
                    for (int n = 0; n < 2; ++n) acc[a][b][m][n] = (f32x4){0.f, 0.f, 0.f, 0.f};
        cur = nxt; cA = nA; cB = nB; ++ui;
        if (wr == 1) PG8_BAR;
    }
    PG8_WAIT_V(0);
    PG8_BAR;
#undef PG8_SA
#undef PG8_SB
#undef PG8_STAGE
#undef PG8_LDA
#undef PG8_LDB
#undef PG8_MMA
#undef PG8_WAIT_V
#undef PG8_WAIT_L
#undef PG8_BAR
#undef PG8_SCHED
}
}

struct Args { const float* in[20]; float* out; unsigned char* ws; int ph_lo, ph_hi; };

struct Ctx {
    LAS unsigned char* lds; int tid, G, bid;
    const float* const* in; float* out; unsigned char* ws;
};
__device__ __forceinline__ unsigned char* ws_launder(unsigned char* p) { asm volatile("" : "+s"(p)); return p; }
#define WSP(T_, off) ((T_*)(ws_launder(C.ws) + (off)))

__device__ __forceinline__ int abmap(int n) { const int blk = n >> 9; return (int)((0x6514320u >> (4 * blk)) & 15u) * 512 + (n & 511); }
__device__ __forceinline__ void tr_item(const float* W, int K, int N, bf16_t* WT, const float* gain, int mapmode, LAS float* scr, int item, int lane, int cs_lo = 0, int cs_hi = 0, float cs = 1.f) {
    const int nblk = (N + 31) / 32, kb = item / nblk, nb = item % nblk, k0 = 64 * kb, n0 = 32 * nb;
    const int nl = lane & 31, n = n0 + nl, c = lane & 7;
    float v[32];
    const float* wp = W + (size_t)(k0 + (lane >> 5)) * N + (n < N ? n : 0);
#pragma unroll
    for (int i = 0; i < 32; ++i) v[i] = wp[(size_t)(2 * i) * N];
    f32x4 g0 = (f32x4){1.f, 1.f, 1.f, 1.f}, g1 = g0;
    if (gain) { g0 = *(const f32x4*)(gain + k0 + 8 * c); g1 = *(const f32x4*)(gain + k0 + 8 * c + 4); }
    const float csn = (n >= cs_lo && n < cs_hi) ? cs : 1.f;
#pragma unroll
    for (int i = 0; i < 32; ++i) scr[(2 * i + (lane >> 5)) * 33 + nl] = v[i] * csn;
    LDS_WAIT();
#pragma unroll
    for (int j = 0; j < 4; ++j) { const int nn = (lane >> 3) + 8 * j, ns = n0 + nn;
        if (ns < N) { const int drow = mapmode ? abmap(ns) : ns; const LAS float* s = scr + (8 * c) * 33 + nn;
            u32x4 o; o.x = pk2(s[0 * 33] * g0[0], s[1 * 33] * g0[1]); o.y = pk2(s[2 * 33] * g0[2], s[3 * 33] * g0[3]); o.z = pk2(s[4 * 33] * g1[0], s[5 * 33] * g1[1]); o.w = pk2(s[6 * 33] * g1[2], s[7 * 33] * g1[3]);
            *(u32x4*)(WT + (size_t)drow * K + k0 + 8 * c) = o; } }
    LDS_WAIT();
}
__device__ __forceinline__ void conv_layer(const Ctx& C, int l, int part) {
    LAS float* scr = (LAS float*)(C.lds + __builtin_amdgcn_readfirstlane(C.tid >> 6) * 16384);
    bf16_t* WB = WSP(bf16_t, WS_W0 + (size_t)(l & 1) * WS_WSTRIDE);
    const int wv_ = __builtin_amdgcn_readfirstlane(C.tid >> 6);
    const int gw = part == 1 ? (C.bid - C.G / 2) * 8 + wv_ : C.bid * 8 + wv_, NGW = part == 1 ? (C.G / 2) * 8 : C.G * 8;
    const bool even = (l & 1) == 0; const int sub = l >> 1;
    const int n_in = even ? AB_IN : C_IN;
    const int i0 = 16 * ((n_in + 31) / 32), i1 = 16 * 32, i2 = 16 * 32, i3 = 16 * 64, i4 = 16 * 32, i5 = 16 * 128, i6 = 64 * 32;
    const int tot = i0 + i1 + i2 + i3 + i4 + i5 + i6;
    const int split = (tot * 2) / 5, it_lo = part == 2 ? split : 0, it_hi = part == 1 ? split : tot;
    for (int it = it_lo + gw; it < it_hi; it += NGW) {
        int r = it;
        if (r < i0) { tr_item(even ? C.in[7] + (size_t)sub * D * AB_IN : C.in[12] + (size_t)sub * D * C_IN, D, n_in, WB + WO_IN, C.in[2] + l * D, even ? 1 : 0, scr, r, (C.tid & 63), even ? 2048 : 0, even ? 2560 : 1024, 0.125f * LOG2E); continue; } r -= i0;
        if (r < i1) { tr_item(even ? C.in[11] + (size_t)sub * D * D : C.in[14] + (size_t)sub * D * D, D, D, WB + WO_OUT, nullptr, 0, scr, r, (C.tid & 63)); continue; } r -= i1;
        if (r < i2) { tr_item(C.in[15] + (size_t)l * D * D, D, D, WB + WO_XQ, C.in[3] + l * D, 0, scr, r, (C.tid & 63), 0, D, 0.0625f * LOG2E); continue; } r -= i2;
        if (r < i3) { tr_item(C.in[16] + (size_t)l * D * 2 * D, D, 2 * D, WB + WO_XKV, C.in[4] + l * D, 0, scr, r, (C.tid & 63)); continue; } r -= i3;
        if (r < i4) { tr_item(C.in[17] + (size_t)l * D * D, D, D, WB + WO_XO, nullptr, 0, scr, r, (C.tid & 63)); continue; } r -= i4;
        if (r < i5) { tr_item(C.in[18] + (size_t)l * D * FF, D, FF, WB + WO_UP, C.in[5] + l * D, 0, scr, r, (C.tid & 63)); continue; } r -= i5;
        tr_item(C.in[19] + (size_t)l * FF * D, FF, D, WB + WO_DOWN, nullptr, 0, scr, r, (C.tid & 63));
    }
}
__device__ __forceinline__ float row_to_bf16(const float* xrow, bf16_t* orow, int lane) {
    const f32x4* xr = (const f32x4*)xrow + lane; float s = 0.f;
    unsigned long long* o8 = (unsigned long long*)orow + lane;
#pragma unroll
    for (int j = 0; j < 4; ++j) { const f32x4 v = xr[64 * j]; s += (v[0] * v[0] + v[1] * v[1]) + (v[2] * v[2] + v[3] * v[3]);
        o8[64 * j] = (unsigned long long)pk2(v[0], v[1]) | ((unsigned long long)pk2(v[2], v[3]) << 32); }
    return wave_sum(s);
}
__device__ __forceinline__ void prologue(const Ctx& C) {
    const int gw = C.bid * 8 + __builtin_amdgcn_readfirstlane(C.tid >> 6), NGW = C.G * 8;
    bf16_t* HB = WSP(bf16_t, WS_HB); float* RSS = WSP(float, WS_RSS);
    for (int m = gw; m < T; m += NGW) { const float ss = row_to_bf16(C.in[0] + (size_t)m * D, HB + (size_t)m * D, (C.tid & 63));
        if ((C.tid & 63) < 16) RSS[(size_t)m * 16 + (C.tid & 63)] = (C.tid & 63) == 0 ? ss : 0.f; }
    bf16_t* MB = WSP(bf16_t, WS_MEMB); float* RM = WSP(float, WS_RSTDM);
    for (int m = gw; m < TM; m += NGW) { const float ss = row_to_bf16(C.in[1] + (size_t)m * D, MB + (size_t)m * D, (C.tid & 63));
        if ((C.tid & 63) == 0) RM[m] = rsqrtf(ss * (1.0f / D) + EPS); }
}
__device__ __forceinline__ void final_norm(const Ctx& C) {
    const int gw = C.bid * 8 + __builtin_amdgcn_readfirstlane(C.tid >> 6), NGW = C.G * 8; const float* gn = C.in[6]; const bf16_t* HB = WSP(bf16_t, WS_HB);
    for (int m = gw; m < T; m += NGW) { const u32x2* hr = (const u32x2*)(HB + (size_t)m * D) + (C.tid & 63); f32x4* xr = (f32x4*)(C.out + (size_t)m * D) + (C.tid & 63); f32x4 v[4]; float s = 0.f;
#pragma unroll
        for (int j = 0; j < 4; ++j) { const u32x2 b = hr[64 * j]; v[j] = (f32x4){__uint_as_float(b.x << 16), __uint_as_float(b.x & 0xffff0000u), __uint_as_float(b.y << 16), __uint_as_float(b.y & 0xffff0000u)};
            s += (v[j][0] * v[j][0] + v[j][1] * v[j][1]) + (v[j][2] * v[j][2] + v[j][3] * v[j][3]); }
        const float rstd = rsqrtf(wave_sum(s) * (1.0f / D) + EPS);
#pragma unroll
        for (int j = 0; j < 4; ++j) { const f32x4 g4 = ((const f32x4*)gn)[(C.tid & 63) + 64 * j]; xr[64 * j] = v[j] * rstd * g4; } }
}

__device__ __forceinline__ float log_sigmoid(float x) { return fminf(x, 0.f) - log1pf(__expf(-fabsf(x))); }
__device__ __forceinline__ float sigmoidf_(float x) { return 1.0f / (1.0f + __expf(-x)); }

template <int DH, int MODE>
__device__ __forceinline__ void naive_attn_row(const bf16_t* qrow, const bf16_t* Kb, const bf16_t* Vb, int ldkv, int nk, float scale,
                                               const float* tab, int rel0, const float* cum, int tpos, bf16_t* orow, LAS float* pl, LAS float* ql, int lane) {
#pragma unroll
    for (int j = 0; j < DH / 64; ++j) ql[lane + 64 * j] = bf2f(qrow[lane + 64 * j]);
    LDS_WAIT();
    float mx = -INFINITY;
    for (int k = lane; k < nk; k += 64) {
        const u32x4* kr = (const u32x4*)(Kb + (size_t)k * ldkv); float dot = 0.f;
#pragma unroll 4
        for (int c = 0; c < DH / 8; ++c) { const u32x4 w = kr[c];
#pragma unroll
            for (int e = 0; e < 4; ++e) { dot += ql[c * 8 + 2 * e] * __uint_as_float(w[e] << 16) + ql[c * 8 + 2 * e + 1] * __uint_as_float(w[e] & 0xffff0000u); } }
        float lg = dot * scale;
        if (MODE == 1) { int rel = rel0 - k; rel = rel < -128 ? -128 : (rel > 128 ? 128 : rel); lg += tab[rel + 128]; }
        if (MODE == 2) lg += cum[tpos] - cum[k];
        pl[k] = lg; mx = fmaxf(mx, lg);
    }
    mx = wave_max(mx); float sum = 0.f;
    for (int k = lane; k < nk; k += 64) { const float e = __expf(pl[k] - mx); pl[k] = e; sum += e; }
    sum = wave_sum(sum); LDS_WAIT();
    const float inv = 1.0f / sum;
#pragma unroll
    for (int j = 0; j < DH / 64; ++j) { const int d = lane + 64 * j; float a = 0.f;
        for (int k = 0; k < nk; ++k) a += pl[k] * bf2f(Vb[(size_t)k * ldkv + d]);
        orow[d] = (bf16_t)f2bf(a * inv); }
    LDS_WAIT();
}
__device__ __forceinline__ void naive_band(const Ctx& C, int e) {
    bf16_t* BIG = WSP(bf16_t, WS_BIG); const int gw = C.bid * 8 + __builtin_amdgcn_readfirstlane(C.tid >> 6), NGW = C.G * 8;
    LAS float* pl = (LAS float*)(C.lds + __builtin_amdgcn_readfirstlane(C.tid >> 6) * 9216); LAS float* ql = pl + 2048;
    for (int it = gw; it < T * BH; it += NGW) { const int hd = it % BH, row = it / BH, b = row / SEQ, t = row % SEQ, cq = t / CHUNK;
        const int c0 = cq - 8 < 0 ? 0 : cq - 8, k0 = c0 * CHUNK, nk = (cq + 1) * CHUNK - k0;
        bf16_t* qp = BIG + (size_t)row * AB_IN + COL_QB + hd * BD;
        const bf16_t* kp = BIG + (size_t)(b * SEQ + k0) * AB_IN + COL_KB + hd * BD; const bf16_t* vp = BIG + (size_t)(b * SEQ + k0) * AB_IN + COL_VB + hd * BD;
        naive_attn_row<BD, 1>(qp, kp, vp, AB_IN, nk, 0.125f, C.in[10] + (size_t)(e * BH + hd) * 257, t - k0, nullptr, 0, qp, pl, ql, (C.tid & 63)); }
}
__device__ __forceinline__ void naive_fox_cum(const Ctx& C, int o) {
    const bf16_t* BIG = WSP(bf16_t, WS_BIG); float* cum = WSP(float, WS_FOXC);
    const int g = C.bid * 512 + C.tid;
    if (g < NB * CH) { const int b = g / CH, hd = g % CH; const float fb = C.in[13][o * CH + hd]; float c = 0.f;
        for (int t = 0; t < SEQ; ++t) { c += log_sigmoid(bf2f(BIG[(size_t)(b * SEQ + t) * C_INP + COL_CF + hd]) + fb); cum[(size_t)g * SEQ + t] = c; } }
}
__device__ __forceinline__ void naive_fox(const Ctx& C) {
    bf16_t* BIG = WSP(bf16_t, WS_BIG); const float* cum = WSP(float, WS_FOXC); const int gw = C.bid * 8 + __builtin_amdgcn_readfirstlane(C.tid >> 6), NGW = C.G * 8;
    LAS float* pl = (LAS float*)(C.lds + __builtin_amdgcn_readfirstlane(C.tid >> 6) * 9216); LAS float* ql = pl + 2048;
    for (int it = gw; it < T * CH; it += NGW) { const int hd = it % CH, row = it / CH, b = row / SEQ, t = row % SEQ;
        bf16_t* qp = BIG + (size_t)row * C_INP + COL_CQ + hd * CD;
        const bf16_t* kp = BIG + (size_t)(b * SEQ) * C_INP + COL_CK + hd * CD; const bf16_t* vp = BIG + (size_t)(b * SEQ) * C_INP + COL_CV + hd * CD;
        naive_attn_row<CD, 2>(qp, kp, vp, C_INP, t + 1, 0.125f, nullptr, 0, cum + (size_t)(b * CH + hd) * SEQ, t, qp, pl, ql, (C.tid & 63)); }
}
__device__ __forceinline__ void naive_xattn(const Ctx& C) {
    bf16_t* XQ = WSP(bf16_t, WS_BIG); const bf16_t* KV = WSP(bf16_t, WS_MEMKV); const int gw = C.bid * 8 + __builtin_amdgcn_readfirstlane(C.tid >> 6), NGW = C.G * 8;
    LAS float* pl = (LAS float*)(C.lds + __builtin_amdgcn_readfirstlane(C.tid >> 6) * 9216); LAS float* ql = pl + 2048;
    for (int it = gw; it < T * XH; it += NGW) { const int hd = it % XH, row = it / XH, b = row / SEQ;
        bf16_t* qp = XQ + (size_t)row * D + hd * XD;
        const bf16_t* kp = KV + (size_t)(b * MEMT) * 2 * D + hd * XD; const bf16_t* vp = kp + D;
        naive_attn_row<XD, 0>(qp, kp, vp, 2 * D, MEMT, 0.0625f, nullptr, 0, nullptr, 0, qp, pl, ql, (C.tid & 63)); }
}
__device__ __forceinline__ void naive_hgrn(const Ctx& C, int e) {
    bf16_t* BIG = WSP(bf16_t, WS_BIG);
    LAS float* fL = (LAS float*)C.lds; LAS float* qL = fL + 2048; LAS float* vL = qL + 2048; LAS float* oL = vL + 2048;
    const int dv = C.tid & 127, kq = C.tid >> 7;
    for (int u = C.bid; u < NB * AH; u += C.G) { const int b = u / AH, hd = u % AH;
        float S[32];
#pragma unroll
        for (int i = 0; i < 32; ++i) S[i] = 0.f;
        for (int t0 = 0; t0 < SEQ; t0 += 16) {
            for (int idx = C.tid; idx < 2048; idx += 512) { const int r = idx >> 7, c = idx & 127; const size_t ro = (size_t)(b * SEQ + t0 + r) * AB_IN + hd * AD + c;
                float lb = 0.f; if (e == 1) { const float l0 = C.in[8][hd * AD + c], l1 = C.in[8][512 + hd * AD + c]; lb = 1.0f / (1.0f + __expf(l0 - l1)); }
                const float z = bf2f(BIG[ro + COL_FA]), q = bf2f(BIG[ro + COL_QA]);
                fL[idx] = lb + (1.0f - lb) * sigmoidf_(z); qL[idx] = q * sigmoidf_(q) * 0.08838834764831845f; vL[idx] = bf2f(BIG[ro + COL_IA]); }
            __syncthreads();
#pragma unroll 1
            for (int r = 0; r < 16; ++r) { const float v = vL[r * 128 + dv]; float po = 0.f;
#pragma unroll
                for (int i = 0; i < 32; ++i) { const float f = fL[r * 128 + kq * 32 + i]; S[i] = f * S[i] + (1.0f - f) * v; po += S[i] * qL[r * 128 + kq * 32 + i]; }
                oL[(r * 4 + kq) * 128 + dv] = po; }
            __syncthreads();
#pragma unroll
            for (int rr = 0; rr < 2; ++rr) { const int r = __builtin_amdgcn_readfirstlane(C.tid >> 6) * 2 + rr; float o[2]; float ss = 0.f;
#pragma unroll
                for (int j = 0; j < 2; ++j) { const int d = (C.tid & 63) + 64 * j; o[j] = (oL[(r * 4 + 0) * 128 + d] + oL[(r * 4 + 1) * 128 + d]) + (oL[(r * 4 + 2) * 128 + d] + oL[(r * 4 + 3) * 128 + d]); ss += o[j] * o[j]; }
                const float rstd = rsqrtf(wave_sum(ss) * (1.0f / AD) + EPS);
#pragma unroll
                for (int j = 0; j < 2; ++j) { const int d = (C.tid & 63) + 64 * j; const size_t ro = (size_t)(b * SEQ + t0 + r) * AB_IN + hd * AD + d;
                    const float g = bf2f(BIG[ro + COL_GA]); const float val = o[j] * rstd * C.in[9][e * 512 + hd * AD + d] * (g * sigmoidf_(g));
                    BIG[ro + COL_QA] = (bf16_t)f2bf(val); } }
            __syncthreads();
        }
    }
}

typedef short v4i16_t __attribute__((ext_vector_type(4)));
__device__ __forceinline__ v4i16_t tr_read(const LAS unsigned char* p) { return __builtin_amdgcn_ds_read_tr16_b64_v4i16((LAS v4i16_t*)p); }
typedef float f32x2_t __attribute__((ext_vector_type(2))); typedef __bf16 bf16x2_t __attribute__((ext_vector_type(2)));
__device__ __forceinline__ unsigned cvtpk(float lo, float hi) { f32x2_t v = {lo, hi}; bf16x2_t b = __builtin_convertvector(v, bf16x2_t); return __builtin_bit_cast(unsigned, b); }
__device__ __forceinline__ float max3f(float a, float b, float c) { float r; asm("v_max3_f32 %0, %1, %2, %3" : "=v"(r) : "v"(a), "v"(b), "v"(c)); return r; }
__device__ __forceinline__ int crow(int r, int hi) { return (r & 3) + 8 * (r >> 2) + 4 * hi; }

template <int DH, int MODE, int NSPLIT>
__device__ __forceinline__ void attn_unit(LAS unsigned char* lds, const bf16_t* Qp, int ldq, const bf16_t* Kp, const bf16_t* Vp, int ldkv, bf16_t* Op, int ldo,
                                          int kt0, int kt1, int tq0, float sc2, const LAS float* aux, int tid) {
    constexpr bool DMA = (DH == 256);
    constexpr int KSTR = DMA ? DH * 2 : DH * 2 + 16, KB = 64 * KSTR, VB = 64 * DH * 2, CPR = DH / 8, NCH = DH / 64, ND0 = DH / 32 / NSPLIT, NS = DH / 16, NSUBD = DH / 32;
    const int lane = tid & 63, w = __builtin_amdgcn_readfirstlane(tid >> 6), hi = lane >> 5, l31 = lane & 31;
    const int qg = NSPLIT == 1 ? w : (w & 3), dsel = NSPLIT == 1 ? 0 : (w >> 2);
    const int qloc = qg * 32 + l31, tq = tq0 + qloc;
    bf16x8 qr[NS];
#pragma unroll
    for (int s = 0; s < NS; ++s) qr[s] = *(const bf16x8*)(Qp + (size_t)qloc * ldq + 16 * s + 8 * hi);
    f32x16 o[ND0];
#pragma unroll
    for (int i = 0; i < ND0; ++i)
#pragma unroll
        for (int r = 0; r < 16; ++r) o[i][r] = 0.f;
    float m = -1e30f, l = 0.f;
    const int qfirst = tq0 + qg * 32, cq = qfirst >> 6;
    unsigned kso[NCH], vso[NCH]; size_t gso[NCH];
#pragma unroll
    for (int i = 0; i < NCH; ++i) { const int cidx = tid + 512 * i, row = cidx / CPR, ch = cidx % CPR;
        kso[i] = row * KSTR + ch * 16; vso[i] = ((row >> 3) * NSUBD + (ch >> 2)) * 512 + (row & 7) * 64 + (ch & 3) * 16; gso[i] = (size_t)row * ldkv + ch * 8; }
    const int vlane = (4 * hi + ((lane & 15) >> 2)) * 64 + ((lane >> 4) & 1) * 32 + (lane & 3) * 8;
    constexpr bool PREF = (DH == 64);
    u32x4 kreg[NCH], vreg[NCH];
    unsigned kgo[4], vgo[4];
    if (DMA) {
#pragma unroll
        for (int i = 0; i < 4; ++i) { const int blk = w * 4 + i; { const int row = 2 * blk + (lane >> 5), ch = (lane & 31) ^ (row & 15); kgo[i] = (unsigned)(row * ldkv + ch * 8); }
            { const int sub = 2 * blk + (lane >> 5), within = lane & 31, row = (sub >> 3) * 8 + (within >> 2), ch = (sub & 7) * 4 + (within & 3); vgo[i] = (unsigned)(row * ldkv + ch * 8); } }
    }
#define ATT_DMA_ISSUE(tt, bb) do { _Pragma("unroll") for (int i_ = 0; i_ < 4; ++i_) { \
        __builtin_amdgcn_global_load_lds((const unsigned*)(Kp + (size_t)(tt) * 64 * ldkv + kgo[i_]), (LAS unsigned*)(lds + (bb) * KB + (w * 4 + i_) * 1024), 16, 0, 0); \
        __builtin_amdgcn_global_load_lds((const unsigned*)(Vp + (size_t)(tt) * 64 * ldkv + vgo[i_]), (LAS unsigned*)(lds + 2 * KB + (bb) * VB + (w * 4 + i_) * 1024), 16, 0, 0); } } while (0)
    if (PREF) {
#pragma unroll
        for (int i = 0; i < NCH; ++i) { kreg[i] = *(const u32x4*)(Kp + (size_t)kt0 * 64 * ldkv + gso[i]); vreg[i] = *(const u32x4*)(Vp + (size_t)kt0 * 64 * ldkv + gso[i]); }
#pragma unroll
        for (int i = 0; i < NCH; ++i) { *(LAS u32x4*)(lds + kso[i]) = kreg[i]; *(LAS u32x4*)(lds + 2 * KB + vso[i]) = vreg[i]; }
        __syncthreads();
    }
    if (DMA) ATT_DMA_ISSUE(kt0, 0);
    for (int t = kt0; t < kt1; ++t) {
        const int buf = (t - kt0) & 1;
        if (DMA) {
            asm volatile("s_waitcnt vmcnt(0)" ::: "memory"); __builtin_amdgcn_s_barrier(); asm volatile("" ::: "memory");
            if (t + 1 < kt1) ATT_DMA_ISSUE(t + 1, buf ^ 1);
        }
        if (PREF && t + 1 < kt1) {
#pragma unroll
            for (int i = 0; i < NCH; ++i) { kreg[i] = *(const u32x4*)(Kp + (size_t)(t + 1) * 64 * ldkv + gso[i]); vreg[i] = *(const u32x4*)(Vp + (size_t)(t + 1) * 64 * ldkv + gso[i]); }
        }
        bool active = true, masked = false;
        if (MODE == 1) active = (t >= cq - 8) && (t <= cq);
        if (MODE == 2) { active = (64 * t <= qfirst + 31); masked = (64 * t + 63 > qfirst); }
        if (active) {
            const LAS unsigned char* Kb = lds + buf * KB; const LAS unsigned char* Vb = lds + 2 * KB + buf * VB;
            f32x16 p0, p1;
#pragma unroll
            for (int r = 0; r < 16; ++r) { p0[r] = 0.f; p1[r] = 0.f; }
#pragma unroll
            for (int s = 0; s < NS; ++s) {
                const int kco = DMA ? (((2 * s + hi) ^ (l31 & 15)) * 16) : (16 * s + 8 * hi) * 2;
                const bf16x8 k0 = *(const LAS bf16x8*)(Kb + l31 * KSTR + kco);
                const bf16x8 k1 = *(const LAS bf16x8*)(Kb + (32 + l31) * KSTR + kco);
                p0 = __builtin_amdgcn_mfma_f32_32x32x16_bf16(k0, qr[s], p0, 0, 0, 0);
                p1 = __builtin_amdgcn_mfma_f32_32x32x16_bf16(k1, qr[s], p1, 0, 0, 0);
            }
            if (MODE == 2) {
#pragma unroll
                for (int g = 0; g < 4; ++g) {
                    const f32x4 c0 = *(const LAS f32x4*)(aux + 64 * t + 8 * g + 4 * hi), c1 = *(const LAS f32x4*)(aux + 64 * t + 32 + 8 * g + 4 * hi);
#pragma unroll
                    for (int e = 0; e < 4; ++e) { p0[4 * g + e] -= c0[e]; p1[4 * g + e] -= c1[e]; }
                }
                if (masked) {
#pragma unroll
                    for (int r = 0; r < 16; ++r) { const int kv = 64 * t + crow(r, hi); if (kv > tq) p0[r] = -INFINITY; if (kv + 32 > tq) p1[r] = -INFINITY; }
                }
            } else if (MODE == 1) {
                if (t <= cq - 3) { const float bc = aux[256];
#pragma unroll
                    for (int r = 0; r < 16; ++r) { p0[r] += bc; p1[r] += bc; }
                } else {
#pragma unroll
                    for (int r = 0; r < 16; ++r) { int rel = tq - (64 * t + crow(r, hi)); int i0 = rel > 128 ? 128 : rel, i1 = rel - 32 > 128 ? 128 : rel - 32; i0 = i0 < -128 ? -128 : i0; i1 = i1 < -128 ? -128 : i1;
                        p0[r] += aux[i0 + 128]; p1[r] += aux[i1 + 128]; }
                }
            }
            float mxa = max3f(p0[0], p1[0], p0[1]), mxb = max3f(p1[1], p0[2], p1[2]);
#pragma unroll
            for (int r = 3; r < 15; r += 2) { mxa = max3f(mxa, p0[r], p1[r]); mxb = max3f(mxb, p0[r + 1], p1[r + 1]); }
            mxa = max3f(mxa, p0[15], p1[15]);
            float mx = max3f(mxa, mxb, mxa);
            mx = max3f(mx, __shfl_xor(mx, 32), mx);
            const float mnew = fmaxf(m, mx), alpha = __builtin_amdgcn_exp2f(m - mnew);
            m = mnew; float ls = 0.f;
#pragma unroll
            for (int r = 0; r < 16; ++r) { p0[r] = __builtin_amdgcn_exp2f(p0[r] - mnew); p1[r] = __builtin_amdgcn_exp2f(p1[r] - mnew); ls += p0[r] + p1[r]; }
            l = l * alpha + ls;
#pragma unroll
            for (int i = 0; i < ND0; ++i)
#pragma unroll
                for (int r = 0; r < 16; ++r) o[i][r] *= alpha;
#pragma unroll
            for (int ks = 0; ks < 4; ++ks) {
                u32x4 pw;
                if (ks < 2) { pw.x = cvtpk(p0[8 * ks + 0], p0[8 * ks + 1]); pw.y = cvtpk(p0[8 * ks + 2], p0[8 * ks + 3]); pw.z = cvtpk(p0[8 * ks + 4], p0[8 * ks + 5]); pw.w = cvtpk(p0[8 * ks + 6], p0[8 * ks + 7]); }
                else { const int k2 = ks - 2; pw.x = cvtpk(p1[8 * k2 + 0], p1[8 * k2 + 1]); pw.y = cvtpk(p1[8 * k2 + 2], p1[8 * k2 + 3]); pw.z = cvtpk(p1[8 * k2 + 4], p1[8 * k2 + 5]); pw.w = cvtpk(p1[8 * k2 + 6], p1[8 * k2 + 7]); }
                const bf16x8 pf = __builtin_bit_cast(bf16x8, pw);
#pragma unroll
                for (int i = 0; i < ND0; ++i) { const int d0 = dsel * ND0 + i;
                    const v4i16_t lo = tr_read(Vb + ((2 * ks) * NSUBD + d0) * 512 + vlane), h4 = tr_read(Vb + ((2 * ks + 1) * NSUBD + d0) * 512 + vlane);
                    const bf16x8 vf = (bf16x8){lo[0], lo[1], lo[2], lo[3], h4[0], h4[1], h4[2], h4[3]};
                    o[i] = __builtin_amdgcn_mfma_f32_32x32x16_bf16(vf, pf, o[i], 0, 0, 0); }
            }
        }
        if (PREF) {
            if (t + 1 < kt1) {
#pragma unroll
                for (int i = 0; i < NCH; ++i) { *(LAS u32x4*)(lds + (buf ^ 1) * KB + kso[i]) = kreg[i]; *(LAS u32x4*)(lds + 2 * KB + (buf ^ 1) * VB + vso[i]) = vreg[i]; }
            }
            __syncthreads();
        }
    }
#undef ATT_DMA_ISSUE
    l += __shfl_xor(l, 32);
    const float inv = 1.0f / l;
#pragma unroll
    for (int i = 0; i < ND0; ++i)
#pragma unroll
        for (int g = 0; g < 4; ++g) { u32x2 wv; wv.x = cvtpk(o[i][4 * g] * inv, o[i][4 * g + 1] * inv); wv.y = cvtpk(o[i][4 * g + 2] * inv, o[i][4 * g + 3] * inv);
            *(u32x2*)(Op + (size_t)qloc * ldo + (dsel * ND0 + i) * 32 + 8 * g + 4 * hi) = wv; }
}

constexpr int A64_STG = 16384;
template <int MODE>
__device__ __forceinline__ void attn64_dma(LAS unsigned char* lds, const bf16_t* Qp, int ldq, const bf16_t* Kp, const bf16_t* Vp, int ldkv, bf16_t* Op, int ldo,
                                           int kt0, int kt1, int tq0, const LAS float* aux, int tid) {
    const int lane = tid & 63, w = __builtin_amdgcn_readfirstlane(tid >> 6), hi = lane >> 5, l31 = lane & 31;
    const int qloc = w * 32 + l31, tq = tq0 + qloc;
    bf16x8 qr[4];
#pragma unroll
    for (int s = 0; s < 4; ++s) qr[s] = *(const bf16x8*)(Qp + (size_t)qloc * ldq + 16 * s + 8 * hi);
    f32x16 o[2];
#pragma unroll
    for (int i = 0; i < 2; ++i)
#pragma unroll
        for (int r = 0; r < 16; ++r) o[i][r] = 0.f;
    float m = -1e30f, l = 0.f;
    const int qfirst = tq0 + w * 32, cq = qfirst >> 6;
    const int vlane = (4 * hi + ((lane & 15) >> 2)) * 64 + ((lane >> 4) & 1) * 32 + (lane & 3) * 8;
    unsigned kgo, vgo;
    { const int row = 8 * w + (lane >> 3), ch = (lane & 7) ^ ((row >> 1) & 7); kgo = (unsigned)(row * ldkv + ch * 8); }
    { const int sub = 2 * w + (lane >> 5), within = lane & 31, row = (sub >> 1) * 8 + (within >> 2), ch = (sub & 1) * 4 + (within & 3); vgo = (unsigned)(row * ldkv + ch * 8); }
    const int krd0 = l31 * 128, krd1 = (32 + l31) * 128, ksw = (l31 >> 1) & 7;
#define A64_ISSUE(tt) do { const int st_ = ((tt) - kt0) & 3; \
        __builtin_amdgcn_global_load_lds((const unsigned*)(Kp + (size_t)(tt) * 64 * ldkv + kgo), (LAS unsigned*)(lds + st_ * A64_STG + w * 1024), 16, 0, 0); \
        __builtin_amdgcn_global_load_lds((const unsigned*)(Vp + (size_t)(tt) * 64 * ldkv + vgo), (LAS unsigned*)(lds + st_ * A64_STG + 8192 + w * 1024), 16, 0, 0); } while (0)
    A64_ISSUE(kt0); if (kt0 + 1 < kt1) A64_ISSUE(kt0 + 1);
    for (int tp = kt0; tp < kt1; tp += 2) {
        asm volatile("s_waitcnt vmcnt(0)" ::: "memory");
        __builtin_amdgcn_s_barrier(); asm volatile("" ::: "memory");
        if (tp + 2 < kt1) A64_ISSUE(tp + 2);
        if (tp + 3 < kt1) A64_ISSUE(tp + 3);
#pragma unroll
      for (int jj = 0; jj < 2; ++jj) { const int t = tp + jj; if (t < kt1) {
        bool active = true, masked = false;
        if (MODE == 1) active = (t >= cq - 8) && (t <= cq);
        if (MODE == 2) { active = (64 * t <= qfirst + 31); masked = (64 * t + 63 > qfirst); }
        if (active) {
            const LAS unsigned char* Kb = lds + ((t - kt0) & 3) * A64_STG; const LAS unsigned char* Vb = Kb + 8192;
            f32x16 p0, p1;
#pragma unroll
            for (int r = 0; r < 16; ++r) { p0[r] = 0.f; p1[r] = 0.f; }
#pragma unroll
            for (int s = 0; s < 4; ++s) { const int kco = ((2 * s + hi) ^ ksw) * 16;
                const bf16x8 k0 = *(const LAS bf16x8*)(Kb + krd0 + kco), k1 = *(const LAS bf16x8*)(Kb + krd1 + kco);
                p0 = __builtin_amdgcn_mfma_f32_32x32x16_bf16(k0, qr[s], p0, 0, 0, 0); p1 = __builtin_amdgcn_mfma_f32_32x32x16_bf16(k1, qr[s], p1, 0, 0, 0); }
            if (MODE == 2) {
#pragma unroll
                for (int g = 0; g < 4; ++g) {
                    const f32x4 c0 = *(const LAS f32x4*)(aux + 64 * t + 8 * g + 4 * hi), c1 = *(const LAS f32x4*)(aux + 64 * t + 32 + 8 * g + 4 * hi);
#pragma unroll
                    for (int e = 0; e < 4; ++e) { p0[4 * g + e] -= c0[e]; p1[4 * g + e] -= c1[e]; }
                }
                if (masked) {
#pragma unroll
                    for (int r = 0; r < 16; ++r) { const int kv = 64 * t + crow(r, hi); if (kv > tq) p0[r] = -INFINITY; if (kv + 32 > tq) p1[r] = -INFINITY; }
                }
            } else {
                if (t <= cq - 3) { const float bc = aux[256];
#pragma unroll
                    for (int r = 0; r < 16; ++r) { p0[r] += bc; p1[r] += bc; }
                } else {
#pragma unroll
                    for (int r = 0; r < 16; ++r) { int rel = tq - (64 * t + crow(r, hi)); int i0 = rel > 128 ? 128 : rel, i1 = rel - 32 > 128 ? 128 : rel - 32; i0 = i0 < -128 ? -128 : i0; i1 = i1 < -128 ? -128 : i1;
                        p0[r] += aux[i0 + 128]; p1[r] += aux[i1 + 128]; }
                }
            }
            float mxa = max3f(p0[0], p1[0], p0[1]), mxb = max3f(p1[1], p0[2], p1[2]);
#pragma unroll
            for (int r = 3; r < 15; r += 2) { mxa = max3f(mxa, p0[r], p1[r]); mxb = max3f(mxb, p0[r + 1], p1[r + 1]); }
            mxa = max3f(mxa, p0[15], p1[15]);
            float mx = max3f(mxa, mxb, mxa);
            mx = max3f(mx, __shfl_xor(mx, 32), mx);
            const float mnew = fmaxf(m, mx), alpha = __builtin_amdgcn_exp2f(m - mnew);
            m = mnew; float ls = 0.f;
#pragma unroll
            for (int r = 0; r < 16; ++r) { p0[r] = __builtin_amdgcn_exp2f(p0[r] - mnew); p1[r] = __builtin_amdgcn_exp2f(p1[r] - mnew); ls += p0[r] + p1[r]; }
            l = l * alpha + ls;
#pragma unroll
            for (int i = 0; i < 2; ++i)
#pragma unroll
                for (int r = 0; r < 16; ++r) o[i][r] *= alpha;
#pragma unroll
            for (int ks = 0; ks < 4; ++ks) {
                u32x4 pw;
                if (ks < 2) { pw.x = cvtpk(p0[8 * ks + 0], p0[8 * ks + 1]); pw.y = cvtpk(p0[8 * ks + 2], p0[8 * ks + 3]); pw.z = cvtpk(p0[8 * ks + 4], p0[8 * ks + 5]); pw.w = cvtpk(p0[8 * ks + 6], p0[8 * ks + 7]); }
                else { const int k2 = ks - 2; pw.x = cvtpk(p1[8 * k2 + 0], p1[8 * k2 + 1]); pw.y = cvtpk(p1[8 * k2 + 2], p1[8 * k2 + 3]); pw.z = cvtpk(p1[8 * k2 + 4], p1[8 * k2 + 5]); pw.w = cvtpk(p1[8 * k2 + 6], p1[8 * k2 + 7]); }
                const bf16x8 pf = __builtin_bit_cast(bf16x8, pw);
#pragma unroll
                for (int d0 = 0; d0 < 2; ++d0) {
                    const v4i16_t lo = tr_read(Vb + ((2 * ks) * 2 + d0) * 512 + vlane), h4 = tr_read(Vb + ((2 * ks + 1) * 2 + d0) * 512 + vlane);
                    const bf16x8 vf = (bf16x8){lo[0], lo[1], lo[2], lo[3], h4[0], h4[1], h4[2], h4[3]};
                    o[d0] = __builtin_amdgcn_mfma_f32_32x32x16_bf16(vf, pf, o[d0], 0, 0, 0); }
            }
        }
      } }
    }
#undef A64_ISSUE
    l += __shfl_xor(l, 32);
    const float inv = 1.0f / l;
#pragma unroll
    for (int i = 0; i < 2; ++i)
#pragma unroll
        for (int g = 0; g < 4; ++g) { u32x2 wv; wv.x = cvtpk(o[i][4 * g] * inv, o[i][4 * g + 1] * inv); wv.y = cvtpk(o[i][4 * g + 2] * inv, o[i][4 * g + 3] * inv);
            *(u32x2*)(Op + (size_t)qloc * ldo + i * 32 + 8 * g + 4 * hi) = wv; }
    __syncthreads();
}

constexpr int ATT64_AUX = 4 * A64_STG;
__device__ __forceinline__ void fox_phase(const Ctx& C, int oidx, bool dry) {
    bf16_t* BIG = WSP(bf16_t, WS_BIG);
    LAS float* cl = (LAS float*)(C.lds + ATT64_AUX); LAS float* wtot = cl + SEQ;
    int cur_bh = -1;
    for (int u = C.bid; u < NB * CH * 8; u += C.G) { const int bh = u & 255, qb = u >> 8, b = bh >> 4, hd = bh & 15;
        if (bh != cur_bh) { cur_bh = bh;
            const float fb = C.in[13][oidx * CH + hd]; float s[4]; float run = 0.f;
#pragma unroll
            for (int j = 0; j < 4; ++j) { run += log_sigmoid(bf2f(BIG[(size_t)(b * SEQ + 4 * C.tid + j) * C_INP + COL_CF + hd]) + fb); s[j] = run; }
            float x = run;
#pragma unroll
            for (int off = 1; off < 64; off <<= 1) { const float n = __shfl_up(x, off); if ((C.tid & 63) >= off) x += n; }
            __syncthreads();
            if ((C.tid & 63) == 63) wtot[__builtin_amdgcn_readfirstlane(C.tid >> 6)] = x;
            __syncthreads();
            float pre = 0.f;
            for (int ww = 0; ww < __builtin_amdgcn_readfirstlane(C.tid >> 6); ++ww) pre += wtot[ww];
            const float ex = x - run + pre;
#pragma unroll
            for (int j = 0; j < 4; ++j) cl[4 * C.tid + j] = (ex + s[j]) * LOG2E;
            __syncthreads();
        }
        bf16_t* qp = BIG + (size_t)(b * SEQ + qb * 256) * C_INP + COL_CQ + hd * CD;
        bf16_t* op = dry ? WSP(bf16_t, WS_HG) + (size_t)(b * SEQ + qb * 256) * 1024 + hd * CD : qp;
        attn64_dma<2>(C.lds, qp, C_INP, BIG + (size_t)(b * SEQ) * C_INP + COL_CK + hd * CD, BIG + (size_t)(b * SEQ) * C_INP + COL_CV + hd * CD, C_INP, op, dry ? 1024 : C_INP,
                            0, 4 * qb + 4, qb * 256, cl, C.tid);
    }
}
__device__ __forceinline__ void band_phase(const Ctx& C, int e, bool dry) {
    bf16_t* BIG = WSP(bf16_t, WS_BIG);
    LAS float* tabL = (LAS float*)(C.lds + ATT64_AUX);
    for (int u = C.bid; u < NB * BH * 8; u += C.G) { const int i = u >> 8, v = u & 255; int g, hd, b;
        if (C.G == 256) { const int x = v & 7, jj = (v >> 3) + 32 * i, bhd = x * 16 + (jj >> 3); g = ((jj & 7) + 2 * i) & 7; b = bhd >> 3; hd = bhd & 7; }
        else { g = ((v & 7) + 2 * i) & 7; hd = (v >> 3) & 7; b = (v >> 6) + 4 * i; }
        __syncthreads();
        if (C.tid < 257) tabL[C.tid] = C.in[10][(size_t)(e * BH + hd) * 257 + C.tid] * LOG2E;
        __syncthreads();
        bf16_t* qp = BIG + (size_t)(b * SEQ + g * 256) * AB_IN + COL_QB + hd * BD;
        bf16_t* op = dry ? BIG + (size_t)T * AB_IN + (size_t)(b * SEQ + g * 256) * 512 + hd * BD : qp;
        attn64_dma<1>(C.lds, qp, AB_IN, BIG + (size_t)(b * SEQ) * AB_IN + COL_KB + hd * BD, BIG + (size_t)(b * SEQ) * AB_IN + COL_VB + hd * BD, AB_IN, op, dry ? 512 : AB_IN,
                            4 * g - 8 < 0 ? 0 : 4 * g - 8, 4 * g + 4, g * 256, tabL, C.tid);
    }
}
__device__ __forceinline__ void xattn_unit2(LAS unsigned char* lds, const bf16_t* Qp, const bf16_t* Kp, const bf16_t* Vp, bf16_t* Op, int tid) {
    constexpr int SLOT = 32768, LDQ = D, LDKV = 2 * D;
    const int lane = tid & 63, w = __builtin_amdgcn_readfirstlane(tid >> 6), hi = lane >> 5, l31 = lane & 31, qloc = w * 32 + l31;
    const int vlane = (4 * hi + ((lane & 15) >> 2)) * 64 + ((lane >> 4) & 1) * 32 + (lane & 3) * 8;
#define XA_ISSUE(idx) do { const bf16_t* src_ = ((idx) < 8 ? Kp : Vp) + (size_t)((idx) & 3) * 64 * LDKV; _Pragma("unroll") for (int i_ = 0; i_ < 4; ++i_) { const int blk_ = w * 4 + i_; unsigned go_; \
        if ((idx) < 8) { const int row_ = 2 * blk_ + (lane >> 5), ch_ = (lane & 31) ^ (row_ & 15); go_ = (unsigned)(row_ * LDKV + ch_ * 8); } \
        else { const int sub_ = 2 * blk_ + (lane >> 5), within_ = lane & 31, row_ = (sub_ >> 3) * 8 + (within_ >> 2), ch_ = (sub_ & 7) * 4 + (within_ & 3); go_ = (unsigned)(row_ * LDKV + ch_ * 8); } \
        __builtin_amdgcn_global_load_lds((const unsigned*)(src_ + go_), (LAS unsigned*)(lds + ((idx) & 3) * SLOT + blk_ * 1024), 16, 0, 0); } } while (0)
#define XA_WAIT(n) asm volatile("s_waitcnt vmcnt(" #n ")" ::: "memory")
#define XA_BAR() do { __builtin_amdgcn_s_barrier(); asm volatile("" ::: "memory"); } while (0)
    XA_ISSUE(0); XA_ISSUE(1); XA_ISSUE(2);
    f32x16 S[8];
#pragma unroll
    for (int j = 0; j < 8; ++j)
#pragma unroll
        for (int r = 0; r < 16; ++r) S[j][r] = 0.f;
#pragma unroll
    for (int pass = 0; pass < 2; ++pass) {
        bf16x8 qr[8];
#pragma unroll
        for (int s = 0; s < 8; ++s) qr[s] = *(const bf16x8*)(Qp + (size_t)qloc * LDQ + 16 * (8 * pass + s) + 8 * hi);
#pragma unroll
        for (int i = 0; i < 4; ++i) {
            XA_WAIT(8); XA_BAR();
            XA_ISSUE(4 * pass + i + 3);
            const LAS unsigned char* Kb = lds + i * SLOT;
#pragma unroll
            for (int ss = 0; ss < 8; ++ss) { const int s = 8 * pass + ss; const int kco = ((2 * s + hi) ^ (l31 & 15)) * 16;
                const bf16x8 k0 = *(const LAS bf16x8*)(Kb + l31 * 512 + kco), k1 = *(const LAS bf16x8*)(Kb + (32 + l31) * 512 + kco);
                S[2 * i] = __builtin_amdgcn_mfma_f32_32x32x16_bf16(k0, qr[ss], S[2 * i], 0, 0, 0); S[2 * i + 1] = __builtin_amdgcn_mfma_f32_32x32x16_bf16(k1, qr[ss], S[2 * i + 1], 0, 0, 0); }
            __builtin_amdgcn_sched_barrier(0);
        }
    }
    float mx = S[0][0];
#pragma unroll
    for (int j = 0; j < 8; ++j)
#pragma unroll
        for (int r = 0; r < 16; ++r) mx = fmaxf(mx, S[j][r]);
    mx = fmaxf(mx, __shfl_xor(mx, 32));
    float l = 0.f; u32x4 pw[16];
#pragma unroll
    for (int j = 0; j < 8; ++j) {
#pragma unroll
        for (int r = 0; r < 16; ++r) { S[j][r] = __builtin_amdgcn_exp2f(S[j][r] - mx); l += S[j][r]; }
#pragma unroll
        for (int k2 = 0; k2 < 2; ++k2) { u32x4 t4; t4.x = cvtpk(S[j][8 * k2 + 0], S[j][8 * k2 + 1]); t4.y = cvtpk(S[j][8 * k2 + 2], S[j][8 * k2 + 3]); t4.z = cvtpk(S[j][8 * k2 + 4], S[j][8 * k2 + 5]); t4.w = cvtpk(S[j][8 * k2 + 6], S[j][8 * k2 + 7]); pw[2 * j + k2] = t4; }
        __builtin_amdgcn_sched_barrier(0);
    }
    l += __shfl_xor(l, 32);
    const float inv = 1.0f / l;
    f32x16 o[8];
#pragma unroll
    for (int i = 0; i < 8; ++i)
#pragma unroll
        for (int r = 0; r < 16; ++r) o[i][r] = 0.f;
#pragma unroll
    for (int t = 0; t < 4; ++t) {
        if (t < 2) XA_WAIT(8); else if (t == 2) XA_WAIT(4); else XA_WAIT(0);
        XA_BAR();
        if (t == 0) XA_ISSUE(11);
        const LAS unsigned char* Vb = lds + t * SLOT;
#pragma unroll
        for (int ks = 0; ks < 4; ++ks) { const bf16x8 pf = __builtin_bit_cast(bf16x8, pw[4 * t + ks]);
#pragma unroll
            for (int d0 = 0; d0 < 8; ++d0) {
                const v4i16_t lo = tr_read(Vb + ((2 * ks) * 8 + d0) * 512 + vlane), h4 = tr_read(Vb + ((2 * ks + 1) * 8 + d0) * 512 + vlane);
                const bf16x8 vf = (bf16x8){lo[0], lo[1], lo[2], lo[3], h4[0], h4[1], h4[2], h4[3]};
                o[d0] = __builtin_amdgcn_mfma_f32_32x32x16_bf16(vf, pf, o[d0], 0, 0, 0);
                if ((d0 & 1) == 1) __builtin_amdgcn_sched_barrier(0); } }
    }
#pragma unroll
    for (int i = 0; i < 8; ++i)
#pragma unroll
        for (int g = 0; g < 4; ++g) { u32x2 wv; wv.x = cvtpk(o[i][4 * g] * inv, o[i][4 * g + 1] * inv); wv.y = cvtpk(o[i][4 * g + 2] * inv, o[i][4 * g + 3] * inv);
            *(u32x2*)(Op + (size_t)qloc * LDQ + i * 32 + 8 * g + 4 * hi) = wv; }
#undef XA_ISSUE
#undef XA_WAIT
#undef XA_BAR
}
__device__ __forceinline__ void xattn_phase(const Ctx& C, bool dry) {
    bf16_t* XQ = WSP(bf16_t, WS_BIG); const bf16_t* KV = WSP(bf16_t, WS_MEMKV);
    for (int u = C.bid; u < NB * XH * 8; u += C.G) { int qblk, hd, b;
        if (C.G == 256) { const int i = u >> 8, v = u & 255, x = v & 7, jj = (v >> 3) + 32 * i, bhd = x * 8 + (jj >> 3); qblk = jj & 7; b = bhd >> 2; hd = bhd & 3; }
        else { qblk = u & 7; hd = (u >> 3) & 3; b = u >> 5; }
        bf16_t* qp = XQ + (size_t)(b * SEQ + qblk * 256) * D + hd * XD;
        const bf16_t* kp = KV + (size_t)(b * MEMT) * 2 * D + hd * XD;
        bf16_t* op = dry ? qp + (size_t)T * D : qp;
        xattn_unit2(C.lds, qp, kp, kp + D, op, C.tid);
    }
}

constexpr int HG_QP = 0, HG_KP = 17408, HG_KE = 34816, HG_V = 51200, HG_GS = 67584;
__device__ __forceinline__ float fast_sigmoid(float x) { return __builtin_amdgcn_rcpf(1.0f + __builtin_amdgcn_exp2f(-x * LOG2E)); }
__device__ __forceinline__ void hgrn_pass1(const Ctx& C, int e) {
    bf16_t* BIG = WSP(bf16_t, WS_BIG); bf16_t* HG = WSP(bf16_t, WS_HG); bf16_t* AM = WSP(bf16_t, WS_AMAT); float* DEC = WSP(float, WS_DEC);
    LAS unsigned char* L = C.lds; LAS float* gs = (LAS float*)(L + HG_GS);
    const int cp = C.tid & 63, rg = C.tid >> 6, lane = (C.tid & 63), w = __builtin_amdgcn_readfirstlane(C.tid >> 6), hi = lane >> 5, l31 = lane & 31;
    const int vlane = (4 * hi + ((lane & 15) >> 2)) * 64 + ((lane >> 4) & 1) * 32 + (lane & 3) * 8;
    unsigned zr[8], qr8[8], vr[8];
    { const int item = C.bid; if (item < NB * AH * 32) { const int n = item & 31, hd = (item >> 5) & 3, b = item >> 7; const bf16_t* p = BIG + ((size_t)b * SEQ + n * 64 + 8 * rg) * AB_IN + hd * AD + 2 * cp;
#pragma unroll
        for (int r = 0; r < 8; ++r) { zr[r] = *(const unsigned*)(p + (size_t)r * AB_IN + COL_FA); qr8[r] = *(const unsigned*)(p + (size_t)r * AB_IN + COL_QA); vr[r] = *(const unsigned*)(p + (size_t)r * AB_IN + COL_IA); } } }
    for (int item = C.bid; item < NB * AH * 32; item += C.G) { const int n = item & 31, hd = (item >> 5) & 3, b = item >> 7; const size_t tok0 = (size_t)b * SEQ + n * 64;
        float lb[2] = {0.f, 0.f};
        if (e == 1) {
#pragma unroll
            for (int j = 0; j < 2; ++j) { const float l0 = C.in[8][hd * AD + 2 * cp + j], l1 = C.in[8][512 + hd * AD + 2 * cp + j]; lb[j] = 1.0f / (1.0f + __expf(l0 - l1)); } }
        bf16_t* p = BIG + (tok0 + 8 * rg) * AB_IN + hd * AD + 2 * cp;
        float bl[8][2], kk[8][2], qs[8][2]; float run[2] = {0.f, 0.f};
#pragma unroll
        for (int r = 0; r < 8; ++r)
#pragma unroll
            for (int j = 0; j < 2; ++j) { const float z = fmaxf(j ? __uint_as_float(zr[r] & 0xffff0000u) : __uint_as_float(zr[r] << 16), -60.f), q = j ? __uint_as_float(qr8[r] & 0xffff0000u) : __uint_as_float(qr8[r] << 16);
                const float sg = fast_sigmoid(z), f = lb[j] + (1.0f - lb[j]) * sg; kk[r][j] = (1.0f - lb[j]) * (1.0f - sg);
                run[j] += __builtin_amdgcn_logf(f); bl[r][j] = run[j]; qs[r][j] = q * fast_sigmoid(q) * 0.08838834764831845f; }
        unsigned vkeep[8];
#pragma unroll
        for (int r = 0; r < 8; ++r) vkeep[r] = vr[r];
        *(LAS float*)(gs + rg * 128 + 2 * cp) = run[0]; *(LAS float*)(gs + rg * 128 + 2 * cp + 1) = run[1];
        __syncthreads();
        float base[2] = {0.f, 0.f}, blast[2] = {0.f, 0.f}, bmid[2] = {0.f, 0.f};
#pragma unroll
        for (int i = 0; i < 8; ++i)
#pragma unroll
            for (int j = 0; j < 2; ++j) { const float g = gs[i * 128 + 2 * cp + j]; if (i < rg) base[j] += g; if (i < 4) bmid[j] += g; blast[j] += g; }
#pragma unroll
        for (int r = 0; r < 8; ++r) { const int row = 8 * rg + r; float qp[2], kp[2], ke[2], qi[2];
#pragma unroll
            for (int j = 0; j < 2; ++j) { const float br = base[j] + bl[r][j]; float ep = br - bmid[j]; ep = ep > 110.f ? 110.f : (ep < -110.f ? -110.f : ep);
                qp[j] = qs[r][j] * __builtin_amdgcn_exp2f(ep); kp[j] = kk[r][j] * __builtin_amdgcn_exp2f(-ep); ke[j] = kk[r][j] * __builtin_amdgcn_exp2f(blast[j] - br); qi[j] = qs[r][j] * __builtin_amdgcn_exp2f(br); }
            *(LAS unsigned*)(L + HG_QP + row * 272 + cp * 4) = cvtpk(qp[0], qp[1]);
            *(LAS unsigned*)(L + HG_KP + row * 272 + cp * 4) = cvtpk(kp[0], kp[1]);
            const int so = ((row >> 3) * 4 + (cp >> 4)) * 512 + (row & 7) * 64 + (cp & 15) * 4;
            *(LAS unsigned*)(L + HG_KE + so) = cvtpk(ke[0], ke[1]);
            *(LAS unsigned*)(L + HG_V + so) = vkeep[r];
            *(unsigned*)(p + (size_t)r * AB_IN + COL_QA) = cvtpk(qi[0], qi[1]); }
        if (rg == 0) { DEC[(size_t)item * 128 + 2 * cp] = __builtin_amdgcn_exp2f(blast[0]); DEC[(size_t)item * 128 + 2 * cp + 1] = __builtin_amdgcn_exp2f(blast[1]); }
        __syncthreads();
        { const int nitem = item + C.G; if (nitem < NB * AH * 32) { const int n2 = nitem & 31, hd2 = (nitem >> 5) & 3, b2 = nitem >> 7; const bf16_t* p2 = BIG + ((size_t)b2 * SEQ + n2 * 64 + 8 * rg) * AB_IN + hd2 * AD + 2 * cp;
#pragma unroll
            for (int r = 0; r < 8; ++r) { zr[r] = *(const unsigned*)(p2 + (size_t)r * AB_IN + COL_FA); qr8[r] = *(const unsigned*)(p2 + (size_t)r * AB_IN + COL_QA); vr[r] = *(const unsigned*)(p2 + (size_t)r * AB_IN + COL_IA); } } }
        if (w < 4) { const int tb = w >> 1, sb = w & 1; f32x16 acc;
#pragma unroll
            for (int r = 0; r < 16; ++r) acc[r] = 0.f;
#pragma unroll
            for (int s = 0; s < 8; ++s) { const bf16x8 qf = *(const LAS bf16x8*)(L + HG_QP + (32 * tb + l31) * 272 + (16 * s + 8 * hi) * 2);
                const bf16x8 kf = *(const LAS bf16x8*)(L + HG_KP + (32 * sb + l31) * 272 + (16 * s + 8 * hi) * 2);
                acc = __builtin_amdgcn_mfma_f32_32x32x16_bf16(kf, qf, acc, 0, 0, 0); }
            bf16_t* ao = AM + (size_t)item * 4096 + (32 * tb + l31) * 64 + 32 * sb + 4 * hi; const int t = 32 * tb + l31;
#pragma unroll
            for (int g = 0; g < 4; ++g) { const int s0 = 32 * sb + 8 * g + 4 * hi; u32x2 wv;
                wv.x = cvtpk(s0 <= t ? acc[4 * g] : 0.f, s0 + 1 <= t ? acc[4 * g + 1] : 0.f); wv.y = cvtpk(s0 + 2 <= t ? acc[4 * g + 2] : 0.f, s0 + 3 <= t ? acc[4 * g + 3] : 0.f);
                *(u32x2*)(ao + 8 * g) = wv; }
        }
#pragma unroll
        for (int jj = 0; jj < 2; ++jj) { const int j = 2 * w + jj, db = j >> 2, cb = j & 3; f32x16 acc;
#pragma unroll
            for (int r = 0; r < 16; ++r) acc[r] = 0.f;
#pragma unroll
            for (int ks = 0; ks < 4; ++ks) {
                const v4i16_t v0 = tr_read(L + HG_V + ((2 * ks) * 4 + db) * 512 + vlane), v1 = tr_read(L + HG_V + ((2 * ks + 1) * 4 + db) * 512 + vlane);
                const v4i16_t k0 = tr_read(L + HG_KE + ((2 * ks) * 4 + cb) * 512 + vlane), k1 = tr_read(L + HG_KE + ((2 * ks + 1) * 4 + cb) * 512 + vlane);
                const bf16x8 vf = (bf16x8){v0[0], v0[1], v0[2], v0[3], v1[0], v1[1], v1[2], v1[3]}, kf = (bf16x8){k0[0], k0[1], k0[2], k0[3], k1[0], k1[1], k1[2], k1[3]};
                acc = __builtin_amdgcn_mfma_f32_32x32x16_bf16(kf, vf, acc, 0, 0, 0); }
            bf16_t* ho = HG + (size_t)item * 16384 + (32 * db + l31) * 128 + 32 * cb + 4 * hi;
#pragma unroll
            for (int g = 0; g < 4; ++g) { u32x2 wv; wv.x = cvtpk(acc[4 * g], acc[4 * g + 1]); wv.y = cvtpk(acc[4 * g + 2], acc[4 * g + 3]); *(u32x2*)(ho + 8 * g) = wv; }
        }
        __syncthreads();
    }
}
__device__ __forceinline__ void hgrn_scan(const Ctx& C) {
    bf16_t* HG = WSP(bf16_t, WS_HG); const float* DEC = WSP(float, WS_DEC);
    for (int gid = C.bid * 512 + C.tid; gid < NB * AH * 2048; gid += C.G * 512) { const int bhd = gid >> 11, e8 = gid & 2047, dv = e8 >> 4, c8 = (e8 & 15) * 8;
        float st[8];
#pragma unroll
        for (int i = 0; i < 8; ++i) st[i] = 0.f;
#pragma unroll 4
        for (int n = 0; n < 32; ++n) { const size_t item = (size_t)bhd * 32 + n; u32x4* hp = (u32x4*)(HG + item * 16384 + dv * 128 + c8); const f32x4* dp = (const f32x4*)(DEC + item * 128 + c8);
            const u32x4 up = *hp; const f32x4 d0 = dp[0], d1 = dp[1];
            u32x4 o; o.x = pk2(st[0], st[1]); o.y = pk2(st[2], st[3]); o.z = pk2(st[4], st[5]); o.w = pk2(st[6], st[7]); *hp = o;
#pragma unroll
            for (int i = 0; i < 4; ++i) { const float ulo = __uint_as_float(up[i] << 16), uhi = __uint_as_float(up[i] & 0xffff0000u); const float da = i < 2 ? d0[2 * i] : d1[2 * i - 4], db2 = i < 2 ? d0[2 * i + 1] : d1[2 * i - 3];
                st[2 * i] = da * st[2 * i] + ulo; st[2 * i + 1] = db2 * st[2 * i + 1] + uhi; } }
    }
}
__device__ __forceinline__ void hgrn_pass3(const Ctx& C, int e) {
    bf16_t* BIG = WSP(bf16_t, WS_BIG); const bf16_t* HG = WSP(bf16_t, WS_HG); const bf16_t* AM = WSP(bf16_t, WS_AMAT);
    LAS unsigned char* L = C.lds; LAS float* ssum = (LAS float*)(L + 16384);
    const int lane = (C.tid & 63), w = __builtin_amdgcn_readfirstlane(C.tid >> 6), hi = lane >> 5, l31 = lane & 31, db = w >> 1, tb = w & 1;
    const int vlane = (4 * hi + ((lane & 15) >> 2)) * 64 + ((lane >> 4) & 1) * 32 + (lane & 3) * 8;
    u32x4 vst[2]; bf16x8 sf[8], qf[8]; u32x2 a0[4], a1[4], gv[4]; f32x4 gn[4];
#define P3_LOAD(it_) do { const int n_ = (it_) & 31, hd_ = ((it_) >> 5) & 3, b_ = (it_) >> 7; const size_t tok_ = (size_t)b_ * SEQ + n_ * 64; \
        _Pragma("unroll") for (int i_ = 0; i_ < 2; ++i_) { const int cidx_ = C.tid + 512 * i_, row_ = cidx_ >> 4, ch_ = cidx_ & 15; vst[i_] = *(const u32x4*)(BIG + (tok_ + row_) * AB_IN + COL_IA + hd_ * AD + ch_ * 8); } \
        const bf16_t* sp_ = HG + (size_t)(it_) * 16384 + (32 * db + l31) * 128 + 8 * hi; const bf16_t* qrow_ = BIG + (tok_ + 32 * tb + l31) * AB_IN + hd_ * AD; \
        const bf16_t* ap_ = AM + (size_t)(it_) * 4096 + (32 * tb + l31) * 64 + 4 * hi; \
        _Pragma("unroll") for (int s_ = 0; s_ < 8; ++s_) { sf[s_] = *(const bf16x8*)(sp_ + 16 * s_); qf[s_] = *(const bf16x8*)(qrow_ + COL_QA + 16 * s_ + 8 * hi); } \
        _Pragma("unroll") for (int ks_ = 0; ks_ < 4; ++ks_) { a0[ks_] = *(const u32x2*)(ap_ + 16 * ks_); a1[ks_] = *(const u32x2*)(ap_ + 16 * ks_ + 8); } \
        _Pragma("unroll") for (int g_ = 0; g_ < 4; ++g_) { const int dv0_ = 32 * db + 8 * g_ + 4 * hi; gv[g_] = *(const u32x2*)(qrow_ + COL_GA + dv0_); gn[g_] = *(const f32x4*)(C.in[9] + e * 512 + hd_ * AD + dv0_); } } while (0)
    if (C.bid < NB * AH * 32) P3_LOAD(C.bid);
    for (int item = C.bid; item < NB * AH * 32; item += C.G) { const int n = item & 31, hd = (item >> 5) & 3, b = item >> 7; const size_t tok0 = (size_t)b * SEQ + n * 64;
        bf16_t* qrow = BIG + (tok0 + 32 * tb + l31) * AB_IN + hd * AD;
#pragma unroll
        for (int i = 0; i < 2; ++i) { const int cidx = C.tid + 512 * i, row = cidx >> 4, ch = cidx & 15;
            *(LAS u32x4*)(L + ((row >> 3) * 4 + (ch >> 2)) * 512 + (row & 7) * 64 + (ch & 3) * 16) = vst[i]; }
        __syncthreads();
        f32x16 acc;
#pragma unroll
        for (int r = 0; r < 16; ++r) acc[r] = 0.f;
#pragma unroll
        for (int s = 0; s < 8; ++s) acc = __builtin_amdgcn_mfma_f32_32x32x16_bf16(sf[s], qf[s], acc, 0, 0, 0);
#pragma unroll
        for (int ks = 0; ks < 4; ++ks) {
            const v4i16_t v0 = tr_read(L + ((2 * ks) * 4 + db) * 512 + vlane), v1 = tr_read(L + ((2 * ks + 1) * 4 + db) * 512 + vlane);
            const bf16x8 vf = (bf16x8){v0[0], v0[1], v0[2], v0[3], v1[0], v1[1], v1[2], v1[3]};
            const bf16x8 af = __builtin_bit_cast(bf16x8, (u32x4){a0[ks].x, a0[ks].y, a1[ks].x, a1[ks].y});
            acc = __builtin_amdgcn_mfma_f32_32x32x16_bf16(vf, af, acc, 0, 0, 0); }
        float gg[4][4], gw[4][4];
#pragma unroll
        for (int g = 0; g < 4; ++g) { gg[g][0] = __uint_as_float(gv[g].x << 16); gg[g][1] = __uint_as_float(gv[g].x & 0xffff0000u); gg[g][2] = __uint_as_float(gv[g].y << 16); gg[g][3] = __uint_as_float(gv[g].y & 0xffff0000u);
#pragma unroll
            for (int e2 = 0; e2 < 4; ++e2) gw[g][e2] = gn[g][e2]; }
        float ss = 0.f;
#pragma unroll
        for (int r = 0; r < 16; ++r) ss += acc[r] * acc[r];
        ss += __shfl_xor(ss, 32);
        if (hi == 0) ssum[db * 64 + 32 * tb + l31] = ss;
        __syncthreads();
        if (item + C.G < NB * AH * 32) P3_LOAD(item + C.G);
        const int tl = 32 * tb + l31;
        const float rstd = rsqrtf(((ssum[tl] + ssum[64 + tl]) + (ssum[128 + tl] + ssum[192 + tl])) * (1.0f / AD) + EPS);
#pragma unroll
        for (int g = 0; g < 4; ++g) { const int dv0 = 32 * db + 8 * g + 4 * hi;
            u32x2 o; o.x = cvtpk(acc[4 * g] * rstd * gw[g][0] * (gg[g][0] * fast_sigmoid(gg[g][0])), acc[4 * g + 1] * rstd * gw[g][1] * (gg[g][1] * fast_sigmoid(gg[g][1])));
            o.y = cvtpk(acc[4 * g + 2] * rstd * gw[g][2] * (gg[g][2] * fast_sigmoid(gg[g][2])), acc[4 * g + 3] * rstd * gw[g][3] * (gg[g][3] * fast_sigmoid(gg[g][3])));
            *(u32x2*)(qrow + COL_QA + dv0) = o; }
        __syncthreads();
    }
#undef P3_LOAD
}

enum { K_PRO = 0, K_INPROJ = 1, K_MIXA = 2, K_MIXB = 3, K_MIXC = 4, K_OUTPROJ = 5, K_XQ = 6, K_XATTN = 7, K_XO = 8, K_UP = 9, K_DOWN = 10, K_FINAL = 11 };
constexpr unsigned long long EVEN_KINDS = 0xA987654321ull; constexpr int N_EVEN_PH = 10;
constexpr unsigned long long ODD_KINDS = 0xA9876531ull; constexpr int N_ODD_PH = 8;
constexpr int N_PHASES = 1 + 2 * (N_EVEN_PH + N_ODD_PH) + 1;

#ifndef PROBE_GEMM
#define PROBE_GEMM 1
#endif
#ifndef PROBE_SYNC
#define PROBE_SYNC 1
#endif
#ifndef PROBE_FOX
#define PROBE_FOX 0
#endif
#ifndef PROBE_BAND
#define PROBE_BAND 0
#endif
#ifndef PROBE_XATTN
#define PROBE_XATTN 0
#endif
#define GEMM_SCALE(MODE_, ACT_, M_, N_, K_, LDA_, A_, B_, O_, RS_) for (int rep_ = 0; rep_ < PROBE_GEMM; ++rep_) do { int t2_ = C.tid; asm volatile("" : "+v"(t2_)); pg8::Gemm g{A_, B_}; pg8::EpiScale<MODE_, ACT_, N_> E{O_, RS_}; pg8::StaticOrder S; S.init(M_, N_, C.G, C.bid); \
        pg8::gemm_phase<pg8::EpiScale<MODE_, ACT_, N_>, pg8::StaticOrder, K_, LDA_>(C.lds, g, S, E, t2_); } while (0)
#ifndef PROBE_XO
#define PROBE_XO 0
#endif
#define GEMM_RES(K_, LDA_, A_, B_, BASE_, NREP_) for (int rep_ = NREP_; rep_ >= 0; --rep_) do { int t2_ = C.tid; asm volatile("" : "+v"(t2_)); pg8::Gemm g{A_, B_}; \
        pg8::EpiRes E{HB, RSS}; pg8::StaticOrder S; S.init(T, D, C.G, C.bid); \
        pg8::gemm_phase<pg8::EpiRes, pg8::StaticOrder, K_, LDA_>(C.lds, g, S, E, t2_); } while (0)
#define XB_TMO      128
#define XB_XCNT(j)  (256  + 64 * (j))
#define XB_XSUB(j)  (1280 + 64 * (j))
#define XB_XGEN(j)  (2304 + 64 * (j))
#define XB_TOP      3328
#define XB_TOPGEN   3392
#define XCD_BAR_WORDS 3456
#define XB_SPIN_CAP (1u << 22)

__device__ __forceinline__ unsigned xb_ld(unsigned* p)              { return __hip_atomic_load(p, __ATOMIC_RELAXED, __HIP_MEMORY_SCOPE_AGENT); }
__device__ __forceinline__ unsigned xb_add(unsigned* p, unsigned v) { return __hip_atomic_fetch_add(p, v, __ATOMIC_RELAXED, __HIP_MEMORY_SCOPE_AGENT); }
__device__ __forceinline__ unsigned xb_xcc_id() { return (unsigned)__builtin_amdgcn_s_getreg((3 << 11) | 20) & 0xFu; }
#define XB_SPIN(cond, bar) do { unsigned _sp = 0; while (cond) { __builtin_amdgcn_s_sleep(1); \
    if ((++_sp & 255u) == 0u) { if (xb_ld(&(bar)[XB_TMO])) break; if (_sp > XB_SPIN_CAP) { atomicAdd(&(bar)[XB_TMO], 1u); break; } } } } while (0)

struct XcdBarrier {
    unsigned* bar; unsigned x;
    volatile LAS unsigned* st;
};

__device__ __forceinline__ XcdBarrier xcd_barrier_post(unsigned* bar, volatile LAS unsigned* st) {
    XcdBarrier b; b.bar = bar; b.x = xb_xcc_id(); b.st = st;
    if (threadIdx.x == 0) (void)xb_add(&bar[XB_XCNT(b.x)], 1u);
    return b;
}
__device__ __forceinline__ void xcd_barrier_complete(unsigned* bar, unsigned x, unsigned& nloc, unsigned& nx) {
    const unsigned G = gridDim.x * gridDim.y * gridDim.z;
    unsigned sum, cnt, mine, sp = 0u;
    for (;;) {
        sum = 0u; cnt = 0u; mine = 0u;
#pragma unroll
        for (unsigned j = 0; j < 16; ++j) { const unsigned c = xb_ld(&bar[XB_XCNT(j)]); sum += c; cnt += (c > 0u) ? 1u : 0u; mine = (j == x) ? c : mine; }
        if (sum == G) break;
        __builtin_amdgcn_s_sleep(1);
        if ((++sp & 255u) == 0u) { if (xb_ld(&bar[XB_TMO])) break; if (sp > XB_SPIN_CAP) { atomicAdd(&bar[XB_TMO], 1u); break; } }
    }
    nloc = mine > 0u ? mine : 1u; nx = cnt > 0u ? cnt : 1u;
}

__device__ __forceinline__ void xcd_barrier(const XcdBarrier& b) {
    asm volatile("s_waitcnt vmcnt(0)" ::: "memory");
    __syncthreads();
    if (threadIdx.x == 0) {
        unsigned* bar = b.bar;
        __builtin_amdgcn_s_waitcnt(0);
        unsigned nloc = b.st[0], nx = b.st[1];
        if (nloc == 0u) { xcd_barrier_complete(bar, b.x, nloc, nx); b.st[0] = nloc; b.st[1] = nx; }
        const unsigned old = xb_add(&bar[XB_XSUB(b.x)], 1u);
        const unsigned gen = old / nloc;
        if (old + 1u == (gen + 1u) * nloc) {
            __builtin_amdgcn_fence(__ATOMIC_RELEASE, "agent");
            asm volatile("s_waitcnt vmcnt(0)" ::: "memory");
            const unsigned og = xb_add(&bar[XB_TOP], 1u);
            const unsigned tg = og / nx;
            if (og + 1u == (tg + 1u) * nx) xb_add(&bar[XB_TOPGEN], 1u);
            else XB_SPIN(xb_ld(&bar[XB_TOPGEN]) == tg, bar);
            __builtin_amdgcn_fence(__ATOMIC_ACQUIRE, "agent");
            xb_add(&bar[XB_XGEN(b.x)], 1u);
            asm volatile("s_waitcnt vmcnt(0)" ::: "memory");
        } else {
            XB_SPIN(xb_ld(&bar[XB_XGEN(b.x)]) == gen, bar);
            __builtin_amdgcn_fence(__ATOMIC_ACQUIRE, "agent");
            asm volatile("s_waitcnt vmcnt(0)" ::: "memory");
        }
    }
    __syncthreads();
}

__global__ void __launch_bounds__(512, 2) mega(Args a) {
    extern __shared__ __attribute__((aligned(16))) unsigned char lds_raw[];
    Ctx C; C.lds = (LAS unsigned char*)lds_raw; C.tid = threadIdx.x;  C.G = gridDim.x; C.bid = blockIdx.x;
    C.in = a.in; C.out = a.out; C.ws = a.ws;
    cg::grid_group grid = cg::this_grid();
    volatile LAS unsigned* MISC = (volatile LAS unsigned*)(C.lds + LDS_BYTES - 64);
    if (threadIdx.x < 16) MISC[threadIdx.x] = 0u;
    __syncthreads();
    const XcdBarrier bar = xcd_barrier_post((unsigned*)a.ws, MISC);
#ifdef TS_MASK
    unsigned long long ts_last = __builtin_amdgcn_s_memrealtime(); unsigned ts_sum = 0u;
#endif
    for (int ph = a.ph_lo; ph < a.ph_hi; ++ph) {
        { int t_ = threadIdx.x; asm volatile("" : "+v"(t_)); C.tid = t_;  }
        { unsigned char* w_ = a.ws; asm volatile("" : "+s"(w_)); C.ws = w_; float* o_ = a.out; asm volatile("" : "+s"(o_)); C.out = o_;
          int b_ = blockIdx.x; asm volatile("" : "+v"(b_)); C.bid = __builtin_amdgcn_readfirstlane(b_); int g_ = gridDim.x; asm volatile("" : "+v"(g_)); C.G = __builtin_amdgcn_readfirstlane(g_); }
        int l = 0, kind;
        if (ph == 0) kind = K_PRO; else if (ph == N_PHASES - 1) kind = K_FINAL;
        else { const int r = ph - 1, pair = r / (N_EVEN_PH + N_ODD_PH), rr = r % (N_EVEN_PH + N_ODD_PH);
            if (rr < N_EVEN_PH) { l = 2 * pair; kind = (int)((EVEN_KINDS >> (4 * rr)) & 15ull); } else { l = 2 * pair + 1; kind = (int)((ODD_KINDS >> (4 * (rr - N_EVEN_PH))) & 15ull); } }
        const bool even = (l & 1) == 0;
        bf16_t* WB = WSP(bf16_t, WS_W0 + (size_t)(l & 1) * WS_WSTRIDE);
        bf16_t* HB = WSP(bf16_t, WS_HB); bf16_t* BIG = WSP(bf16_t, WS_BIG); float* RSS = WSP(float, WS_RSS);
        if (kind == K_PRO) prologue(C);
        else if (kind == K_FINAL) final_norm(C);
        else if (kind == K_INPROJ) {
            if (even) GEMM_SCALE(0, 0, T, AB_IN, D, D, HB, WB + WO_IN, BIG, RSS); else GEMM_SCALE(0, 0, T, C_INP, D, D, HB, WB + WO_IN, BIG, RSS);
        } else if (kind == K_XQ) {
            GEMM_SCALE(0, 0, T, D, D, D, HB, WB + WO_XQ, BIG, RSS);
            GEMM_SCALE(1, 0, TM, 2 * D, D, D, WSP(bf16_t, WS_MEMB), WB + WO_XKV, WSP(bf16_t, WS_MEMKV), WSP(float, WS_RSTDM));
        } else if (kind == K_UP) {
            GEMM_SCALE(0, 1, T, FF, D, D, HB, WB + WO_UP, BIG, RSS);
        } else if (kind == K_OUTPROJ) {
            const float* base = l == 0 ? C.in[0] : C.out;
            if (even) GEMM_RES(D, AB_IN, BIG, WB + WO_OUT, base, 0); else GEMM_RES(D, C_INP, BIG, WB + WO_OUT, base, 0);
        } else if (kind == K_XO) {
            GEMM_RES(D, D, BIG, WB + WO_XO, C.out, PROBE_XO);
        } else if (kind == K_DOWN) {
            GEMM_RES(FF, FF, BIG, WB + WO_DOWN, C.out, 0);
        } else if (kind == K_MIXA) {
            if (even) { hgrn_pass1(C, l >> 1); for (int rep_ = PROBE_BAND; rep_ >= 0; --rep_) { { int t_ = threadIdx.x; asm volatile("" : "+v"(t_)); C.tid = t_;  } band_phase(C, l >> 1, rep_ > 0); } }
        } else if (kind == K_MIXB) {
            if (even) hgrn_scan(C); else for (int rep_ = PROBE_FOX; rep_ >= 0; --rep_) { { int t_ = threadIdx.x; asm volatile("" : "+v"(t_)); C.tid = t_;  } fox_phase(C, l >> 1, rep_ > 0); }
        } else if (kind == K_MIXC) {
            hgrn_pass3(C, l >> 1);
        } else if (kind == K_XATTN) {
            for (int rep_ = PROBE_XATTN; rep_ >= 0; --rep_) { { int t_ = threadIdx.x; asm volatile("" : "+v"(t_)); C.tid = t_;  } xattn_phase(C, rep_ > 0); }
        }
        {
            int cpart = -1, cl = l + 1;
            if (kind == K_PRO) { cpart = 0; cl = 0; }
            else if (kind == K_XQ && l + 1 < DEPTH && C.G == 256 && C.bid >= 128) cpart = 1;
            else if (kind == K_XATTN && l + 1 < DEPTH) cpart = (C.G == 256) ? 2 : 0;
            if (cpart >= 0) { __syncthreads(); conv_layer(C, cl, cpart); }
        }
        if (ph + 1 < a.ph_hi) for (int rep_ = 0; rep_ < PROBE_SYNC; ++rep_) { if (ph == 0) grid.sync(); else xcd_barrier(bar); }
#ifdef TS_MASK
        if (ph + 1 == a.ph_hi) xcd_barrier(bar);
        { const unsigned long long now_ = __builtin_amdgcn_s_memrealtime(); const int kbit = (kind == K_MIXB && even) ? 12 : kind;
          if ((TS_MASK >> kbit) & 1) ts_sum += (unsigned)(now_ - ts_last); ts_last = now_; }
#endif
    }
#ifdef TS_MASK
    if (C.bid == 0) { const unsigned nel = (unsigned)(((unsigned long long)ts_sum * 256ull) / 100ull); for (unsigned i = threadIdx.x; i < nel; i += 512) C.out[i] += 0.0625f; }
#endif
}

#ifndef SINGLE_LAUNCH
#define SINGLE_LAUNCH 1
#endif
extern "C" void kernel_launch(void* const* d_in, const int* in_sizes, int n_in, void* d_out, int out_size, void* d_ws, size_t ws_size, hipStream_t stream) {
    static int grid = 0;
    if (grid == 0) {
        if (n_in != 20 || out_size != T * D || ws_size < WS_END) { fprintf(stderr, "kernel_launch: unexpected shapes (n_in %d out %d ws %zu)\n", n_in, out_size, ws_size); grid = -1; return; }
        int dev = 0, cus = 0, per_cu = 0;
        hipGetDevice(&dev); hipDeviceGetAttribute(&cus, hipDeviceAttributeMultiprocessorCount, dev);
        if (hipFuncSetAttribute((const void*)mega, hipFuncAttributeMaxDynamicSharedMemorySize, LDS_BYTES) != hipSuccess) { fprintf(stderr, "kernel_launch: hipFuncSetAttribute failed\n"); grid = -1; return; }
        if (hipOccupancyMaxActiveBlocksPerMultiprocessor(&per_cu, (const void*)mega, 512, LDS_BYTES) != hipSuccess || per_cu < 1) { fprintf(stderr, "kernel_launch: occupancy query says %d\n", per_cu); per_cu = 1; }
        (void)hipGetLastError();
        grid = cus * 1;
    }
    if (grid < 0) return;
    Args a{};
    for (int i = 0; i < 20; ++i) a.in[i] = (const float*)d_in[i];
    a.out = (float*)d_out; a.ws = (unsigned char*)d_ws;
    if (hipMemsetAsync(d_ws, 0, 16384, stream) != hipSuccess) { fprintf(stderr, "kernel_launch: memset failed\n"); return; }
#if SINGLE_LAUNCH
    a.ph_lo = 0; a.ph_hi = N_PHASES;
    void* args[] = {&a};
    hipError_t e = hipLaunchCooperativeKernel((const void*)mega, dim3(grid), dim3(512), args, LDS_BYTES, stream);
    if (e != hipSuccess) fprintf(stderr, "cooperative launch failed: %s (grid %d)\n", hipGetErrorString(e), grid);
#else
    for (int ph = 0; ph < N_PHASES; ++ph) { a.ph_lo = ph; a.ph_hi = ph + 1; hipLaunchKernelGGL(mega, dim3(grid), dim3(512), LDS_BYTES, stream, a); }
#endif
}
```

```cpp
#include <hip/hip_runtime.h>
#include <hip/hip_cooperative_groups.h>
#include <cstdio>
#include <cstdint>
namespace cg = cooperative_groups;

#define LAS __attribute__((address_space(3)))
typedef unsigned short bf16_t;
typedef short bf16x8 __attribute__((ext_vector_type(8)));
typedef float f32x4 __attribute__((ext_vector_type(4)));
typedef float f32x16 __attribute__((ext_vector_type(16)));
typedef unsigned u32x4 __attribute__((ext_vector_type(4)));
typedef unsigned u32x2 __attribute__((ext_vector_type(2)));

constexpr int D = 1024, NB = 16, SEQ = 2048, T = NB * SEQ, DEPTH = 4, CHUNK = 64, MEMT = 256, TM = NB * MEMT;
constexpr int AH = 4, AD = 128, BH = 8, BD = 64, AB_IN = 3584, CH = 16, CD = 64, C_IN = 3088, C_INP = 3328, XH = 4, XD = 256, FF = 4096;
constexpr float EPS = 1e-6f;
constexpr float LOG2E = 1.4426950408889634f;
constexpr int COL_QA = 0, COL_QB = 512, COL_FA = 1024, COL_IA = 1536, COL_GA = 2048, COL_KB = 2560, COL_VB = 3072;
constexpr int COL_CQ = 0, COL_CK = 1024, COL_CV = 2048, COL_CF = 3072;

constexpr size_t MiB = 1ull << 20;
constexpr size_t WS_RSS = 1 * MiB, WS_RSTDM = 3 * MiB, WS_FOXC = 4 * MiB, WS_DEC = 6 * MiB, WS_MEMB = 8 * MiB, WS_MEMKV = 16 * MiB;
constexpr size_t WS_W0 = 32 * MiB, WS_WSTRIDE = 33 * MiB, WS_HB = 98 * MiB, WS_BIG = 162 * MiB, WS_HG = 418 * MiB, WS_AMAT = 482 * MiB, WS_END = 498 * MiB;
constexpr size_t WO_IN = 0, WO_OUT = (size_t)3584 * 1024, WO_XQ = WO_OUT + 1024 * 1024, WO_XKV = WO_XQ + 1024 * 1024, WO_XO = WO_XKV + 2048 * 1024,
                 WO_UP = WO_XO + 1024 * 1024, WO_DOWN = WO_UP + (size_t)4096 * 1024;
static_assert((WO_DOWN + (size_t)4096 * 1024) * 2 <= WS_WSTRIDE, "weight buffer");

constexpr int LDS_BYTES = 147456;

__device__ __forceinline__ float bf2f(bf16_t v) { return __uint_as_float(((unsigned)v) << 16); }
__device__ __forceinline__ unsigned f2bf(float f) { unsigned u = __float_as_uint(f); return (u + 0x7fffu + ((u >> 16) & 1u)) >> 16; }
__device__ __forceinline__ unsigned pk2(float lo, float hi) { return f2bf(lo) | (f2bf(hi) << 16); }
__device__ __forceinline__ float wave_sum(float v) {
#pragma unroll
    for (int o = 1; o < 64; o <<= 1) v += __shfl_xor(v, o);
    return v;
}
__device__ __forceinline__ float wave_max(float v) {
#pragma unroll
    for (int o = 1; o < 64; o <<= 1) v = fmaxf(v, __shfl_xor(v, o));
    return v;
}
#define LDS_WAIT() asm volatile("s_waitcnt lgkmcnt(0)" ::: "memory")

namespace pg8 {
constexpr int BM = 256, BK = 64, HALF = 128, HTB = HALF * BK * 2, STAGE_BYTES = 8 * HTB, NXCD = 8, WGM = 4;
__host__ __device__ __forceinline__ int lds_byte(int r, int c) { const int st = (r >> 4) * 2 + (c >> 5), rr = r & 15, cc = c & 31, ob = rr * 64 + cc * 2; return st * 1024 + (ob ^ (((ob >> 9) & 1) << 5)); }
__host__ __device__ __forceinline__ void stage_rc(int b, int& R, int& C) { const int st = b / 1024, sb = b % 1024, swz = sb ^ (((sb >> 9) & 1) << 5); R = (st >> 1) * 16 + swz / 64; C = (st & 1) * 32 + (swz % 64) / 2; }
__host__ __device__ __forceinline__ int perm32(int rho) { const int n = rho >> 4, i = rho & 15; return 8 * (i >> 2) + 4 * n + (i & 3); }

struct Unit { int pm, pn; };
struct Gemm { const bf16_t* A; const bf16_t* Bt; };

struct StaticOrder {
    int nM, nN, nwg, G, c;
    __host__ __device__ void init(int M, int N, int G_, int c_) { nM = M / BM; nN = N / BM; nwg = nM * nN; G = G_; c = c_; }
    __host__ __device__ bool next(int i, Unit& u) const {
        const long L = (long)i * G + c; if (L >= nwg) return false;
        int wgid = (int)L; { const int q = nwg / NXCD, r = nwg % NXCD, xcd = wgid % NXCD, off = wgid / NXCD; wgid = (xcd < r ? xcd * (q + 1) : r * (q + 1) + (xcd - r) * q) + off; }
        const int nig = WGM * nN, gid = wgid / nig, fm = gid * WGM, gsz = (nM - fm) < WGM ? (nM - fm) : WGM;
        u.pm = fm + ((wgid % nig) % gsz); u.pn = (wgid % nig) / gsz; return true;
    }
};
__device__ __forceinline__ unsigned cvt_pk_bf16(float lo, float hi) { unsigned r; asm volatile("v_cvt_pk_bf16_f32 %0, %1, %2" : "=v"(r) : "v"(lo), "v"(hi)); return r; }

template <int mode, int act, int ldc> struct EpiScale {
    static constexpr bool PERM = true;
    bf16_t* O; const float* rs;
    __device__ __forceinline__ void operator()(const f32x4 (&acc)[2][2][4][2], const Unit& u, int wr, int wc, int fr, int fq) const {
        const int row0 = u.pm * BM + wr * 64 + fr, col0 = u.pn * BM + wc * 32 + 8 * fq;
        float rstd[8];
        if (mode == 0) {
            f32x4 pr[8];
#pragma unroll
            for (int i = 0; i < 8; ++i) pr[i] = *(const f32x4*)(rs + (size_t)(row0 + (i >> 2) * HALF + (i & 3) * 16) * 16 + 4 * fq);
#pragma unroll
            for (int i = 0; i < 8; ++i) { float ss = (pr[i][0] + pr[i][1]) + (pr[i][2] + pr[i][3]); ss += __shfl_xor(ss, 16); ss += __shfl_xor(ss, 32);
                rstd[i] = rsqrtf(ss * (1.0f / D) + EPS); }
        } else {
#pragma unroll
            for (int i = 0; i < 8; ++i) rstd[i] = rs[row0 + (i >> 2) * HALF + (i & 3) * 16];
        }
#pragma unroll
        for (int ai = 0; ai < 2; ++ai)
#pragma unroll
            for (int m = 0; m < 4; ++m) {
                const int row = row0 + ai * HALF + m * 16; const float rsd = rstd[ai * 4 + m];
                bf16_t* rowp = O + (size_t)row * ldc + col0;
#pragma unroll
                for (int bj = 0; bj < 2; ++bj) { f32x4 v0 = acc[ai][bj][m][0] * rsd, v1 = acc[ai][bj][m][1] * rsd;
                    if (act) {
#pragma unroll
                        for (int e = 0; e < 4; ++e) { const float a0 = fmaxf(v0[e], 0.f), a1 = fmaxf(v1[e], 0.f); v0[e] = a0 * a0; v1[e] = a1 * a1; } }
                    u32x4 w; w.x = cvt_pk_bf16(v0[0], v0[1]); w.y = cvt_pk_bf16(v0[2], v0[3]); w.z = cvt_pk_bf16(v1[0], v1[1]); w.w = cvt_pk_bf16(v1[2], v1[3]);
                    *(u32x4*)(rowp + bj * HALF) = w; }
            }
    }
};
struct EpiRes {
    static constexpr bool PERM = false;
    bf16_t* hb; float* rss;
    __device__ __forceinline__ void operator()(const f32x4 (&acc)[2][2][4][2], const Unit& u, int wr, int wc, int fr, int fq) const {
        const int row0 = u.pm * BM + wr * 64 + fr, col0 = u.pn * BM + wc * 32 + 4 * fq;
#pragma unroll
        for (int ai = 0; ai < 2; ++ai) {
            u32x2 bv[4][2][2];
#pragma unroll
            for (int m = 0; m < 4; ++m)
#pragma unroll
                for (int bj = 0; bj < 2; ++bj)
#pragma unroll
                    for (int n = 0; n < 2; ++n) bv[m][bj][n] = *(const u32x2*)(hb + (size_t)(row0 + ai * HALF + m * 16) * D + col0 + bj * HALF + n * 16);
            asm volatile("" ::: "memory");
#pragma unroll
            for (int m = 0; m < 4; ++m) {
                const int row = row0 + ai * HALF + m * 16; const size_t off = (size_t)row * D + col0; float ss = 0.f;
#pragma unroll
                for (int bj = 0; bj < 2; ++bj)
#pragma unroll
                    for (int n = 0; n < 2; ++n) { const size_t o2 = off + bj * HALF + n * 16; const u32x2 b = bv[m][bj][n]; const f32x4 a = acc[ai][bj][m][n];
                        const float o0 = __uint_as_float(b.x << 16) + a[0], o1 = __uint_as_float(b.x & 0xffff0000u) + a[1], o2f = __uint_as_float(b.y << 16) + a[2], o3 = __uint_as_float(b.y & 0xffff0000u) + a[3];
                        ss += (o0 * o0 + o1 * o1) + (o2f * o2f + o3 * o3);
                        u32x2 w; w.x = cvt_pk_bf16(o0, o1); w.y = cvt_pk_bf16(o2f, o3); *(u32x2*)(hb + o2) = w; }
                ss += __shfl_xor(ss, 16); ss += __shfl_xor(ss, 32);
                if (fq == 0) rss[(size_t)row * 16 + u.pn * 4 + wc] = ss;
            }
            asm volatile("" ::: "memory");
        }
    }
};

template <class Epi, class Sched, int K, int lda>
__device__ __forceinline__ void gemm_phase(LAS unsigned char* lds, const Gemm g, const Sched& S, const Epi& E, const int tid) {
    const int wid = __builtin_amdgcn_readfirstlane(tid >> 6), lane = tid & 63, wr = wid >> 2, wc = wid & 3, fr = lane & 15, fq = lane >> 4;
    constexpr int nt = K / BK;
    unsigned voffA[2], voffB[2];
#pragma unroll
    for (int i = 0; i < 2; ++i) { int R, C; stage_rc(tid * 16 + i * 8192, R, C); const int Rb = Epi::PERM ? ((R & ~31) + perm32(R & 31)) : R;
        voffA[i] = (unsigned)(R * lda + C) * 2u; voffB[i] = (unsigned)(Rb * K + C) * 2u; }
    const size_t kstep = (size_t)(BK * 2);
    const size_t hstepA = (size_t)HALF * lda * 2, hstepB = (size_t)HALF * K * 2;
    const size_t tstepA = 2 * hstepA, tstepB = 2 * hstepB;
    const unsigned ldsw = (unsigned)wid * 1024u;
    const int aoff = lds_byte(wr * 64 + fr, fq * 8), boff = lds_byte(wc * 32 + fr, fq * 8);
#define PG8_SA(b, h) (((b) * 2 + (h)) * HTB)
#define PG8_SB(b, h) ((4 + (b) * 2 + (h)) * HTB)
#define PG8_STAGE(bufoff, gbase, voff) do { _Pragma("unroll") for (int _i = 0; _i < 2; ++_i) \
        __builtin_amdgcn_global_load_lds((const unsigned*)((const char*)(gbase) + (voff)[_i]), (LAS unsigned*)(lds + (bufoff) + ldsw + _i * 8192), 16, 0, 0); } while (0)
#define PG8_LDA(dst, b, h) do { _Pragma("unroll") for (int m = 0; m < 4; ++m) _Pragma("unroll") for (int k = 0; k < 2; ++k) dst[m][k] = *(const LAS bf16x8*)(lds + PG8_SA(b, h) + aoff + m * 2048 + k * 1024); } while (0)
#define PG8_LDB(dst, b, h) do { _Pragma("unroll") for (int n = 0; n < 2; ++n) _Pragma("unroll") for (int k = 0; k < 2; ++k) dst[n][k] = *(const LAS bf16x8*)(lds + PG8_SB(b, h) + boff + n * 2048 + k * 1024); } while (0)
#define PG8_MMA(ai, bj, At, Bt) do { __builtin_amdgcn_s_setprio(1); _Pragma("unroll") for (int m = 0; m < 4; ++m) _Pragma("unroll") for (int n = 0; n < 2; ++n) _Pragma("unroll") for (int k = 0; k < 2; ++k) \
        acc[ai][bj][m][n] = __builtin_amdgcn_mfma_f32_16x16x32_bf16(Bt[n][k], At[m][k], acc[ai][bj][m][n], 0, 0, 0); __builtin_amdgcn_s_setprio(0); } while (0)
#define PG8_WAIT_V(n) asm volatile("s_waitcnt vmcnt(" #n ")" ::: "memory")
#define PG8_WAIT_L(n) asm volatile("s_waitcnt lgkmcnt(" #n ")" ::: "memory")
#define PG8_BAR __builtin_amdgcn_s_barrier()
#define PG8_SCHED __builtin_amdgcn_sched_barrier(0)
    Unit cur, nxt; int ui = 0;
    if (!S.next(0, cur)) return;
    f32x4 acc[2][2][4][2];
#pragma unroll
    for (int a = 0; a < 2; ++a)
#pragma unroll
        for (int b = 0; b < 2; ++b)
#pragma unroll
            for (int m = 0; m < 4; ++m)
#pragma unroll
                for (int n = 0; n < 2; ++n) acc[a][b][m][n] = (f32x4){0.f, 0.f, 0.f, 0.f};
    bf16x8 At[4][2], B0[2][2], B1[2][2];
    const char* cA = (const char*)g.A + (size_t)cur.pm * tstepA; const char* cB = (const char*)g.Bt + (size_t)cur.pn * tstepB;
    PG8_STAGE(PG8_SB(0, 0), cB, voffB); PG8_STAGE(PG8_SB(0, 1), cB + hstepB, voffB); PG8_STAGE(PG8_SA(0, 0), cA, voffA); PG8_STAGE(PG8_SA(0, 1), cA + hstepA, voffA);
    if (wr == 1) PG8_BAR;
    PG8_WAIT_V(2); PG8_BAR;
    PG8_STAGE(PG8_SB(1, 0), cB + kstep, voffB); PG8_STAGE(PG8_SA(1, 0), cA + kstep, voffA); PG8_STAGE(PG8_SB(1, 1), cB + hstepB + kstep, voffB);
    PG8_WAIT_V(6); PG8_BAR;
    for (;;) {
        const bool has_next = S.next(ui + 1, nxt);
        const char* nA = has_next ? (const char*)g.A + (size_t)nxt.pm * tstepA : cA; const char* nB = has_next ? (const char*)g.Bt + (size_t)nxt.pn * tstepB : cB;
        for (int t = 0; t < nt; t += 2) {
            const bool last = (t == nt - 2);
            const char* a1 = cA + (size_t)(t + 1) * kstep;
            const char* a2 = last ? nA : cA + (size_t)(t + 2) * kstep; const char* b2 = last ? nB : cB + (size_t)(t + 2) * kstep;
            const char* a3 = a2 + kstep; const char* b3 = b2 + kstep;
            PG8_LDB(B0, 0, 0); PG8_LDB(B1, 0, 1); PG8_SCHED; PG8_LDA(At, 0, 0); PG8_STAGE(PG8_SA(1, 1), a1 + hstepA, voffA);
            PG8_WAIT_V(8); PG8_WAIT_L(0); PG8_BAR; PG8_MMA(0, 0, At, B0); PG8_MMA(0, 1, At, B1); PG8_BAR; PG8_SCHED;
            PG8_LDA(At, 0, 1); PG8_STAGE(PG8_SB(0, 0), b2, voffB); PG8_STAGE(PG8_SB(0, 1), b2 + hstepB, voffB); PG8_STAGE(PG8_SA(0, 0), a2, voffA);
            PG8_WAIT_V(8); PG8_WAIT_L(0); PG8_BAR; PG8_MMA(1, 0, At, B0); PG8_MMA(1, 1, At, B1); PG8_BAR; PG8_SCHED;
            PG8_LDB(B0, 1, 0); PG8_LDB(B1, 1, 1); PG8_SCHED; PG8_LDA(At, 1, 0); PG8_STAGE(PG8_SA(0, 1), a2 + hstepA, voffA);
            PG8_WAIT_V(8); PG8_WAIT_L(0); PG8_BAR; PG8_MMA(0, 0, At, B0); PG8_MMA(0, 1, At, B1); PG8_BAR; PG8_SCHED;
            PG8_LDA(At, 1, 1); PG8_STAGE(PG8_SB(1, 0), b3, voffB); PG8_STAGE(PG8_SB(1, 1), b3 + hstepB, voffB); PG8_STAGE(PG8_SA(1, 0), a3, voffA);
            PG8_WAIT_V(8); PG8_WAIT_L(0); PG8_BAR; PG8_MMA(1, 0, At, B0); PG8_MMA(1, 1, At, B1); PG8_BAR; PG8_SCHED;
        }
        if (wr == 0) PG8_BAR;
        E(acc, cur, wr, wc, fr, fq);
        if (!has_next) break;
#pragma unroll
        for (int a = 0; a < 2; ++a)
#pragma unroll
            for (int b = 0; b < 2; ++b)
#pragma unroll
                for (int m = 0; m < 4; ++m)
#pragma unroll
                    for (int n = 0; n < 2; ++n) acc[a][b][m][n] = (f32x4){0.f, 0.f, 0.f, 0.f};
        cur = nxt; cA = nA; cB = nB; ++ui;
        if (wr == 1) PG8_BAR;
    }
    PG8_WAIT_V(0);
    PG8_BAR;
#undef PG8_SA
#undef PG8_SB
#undef PG8_STAGE
#undef PG8_LDA
#undef PG8_LDB
#undef PG8_MMA
#undef PG8_WAIT_V
#undef PG8_WAIT_L
#undef PG8_BAR
#undef PG8_SCHED
}
}

struct Args { const float* in[20]; float* out; unsigned char* ws; int ph_lo, ph_hi; };

struct Ctx {
    LAS unsigned char* lds; int tid, G, bid;
    const float* const* in; float* out; unsigned char* ws;
};
__device__ __forceinline__ unsigned char* ws_launder(unsigned char* p) { asm volatile("" : "+s"(p)); return p; }
#define WSP(T_, off) ((T_*)(ws_launder(C.ws) + (off)))

__device__ __forceinline__ int abmap(int n) { const int blk = n >> 9; return (int)((0x6514320u >> (4 * blk)) & 15u) * 512 + (n & 511); }
__device__ __forceinline__ void tr_item(const float* W, int K, int N, bf16_t* WT, const float* gain, int mapmode, LAS float* scr, int item, int lane, int cs_lo = 0, int cs_hi = 0, float cs = 1.f) {
    const int nblk = (N + 31) / 32, kb = item / nblk, nb = item % nblk, k0 = 64 * kb, n0 = 32 * nb;
    const int nl = lane & 31, n = n0 + nl, c = lane & 7;
    float v[32];
    const float* wp = W + (size_t)(k0 + (lane >> 5)) * N + (n < N ? n : 0);
#pragma unroll
    for (int i = 0; i < 32; ++i) v[i] = wp[(size_t)(2 * i) * N];
    f32x4 g0 = (f32x4){1.f, 1.f, 1.f, 1.f}, g1 = g0;
    if (gain) { g0 = *(const f32x4*)(gain + k0 + 8 * c); g1 = *(const f32x4*)(gain + k0 + 8 * c + 4); }
    const float csn = (n >= cs_lo && n < cs_hi) ? cs : 1.f;
#pragma unroll
    for (int i = 0; i < 32; ++i) scr[(2 * i + (lane >> 5)) * 33 + nl] = v[i] * csn;
    LDS_WAIT();
#pragma unroll
    for (int j = 0; j < 4; ++j) { const int nn = (lane >> 3) + 8 * j, ns = n0 + nn;
        if (ns < N) { const int drow = mapmode ? abmap(ns) : ns; const LAS float* s = scr + (8 * c) * 33 + nn;
            u32x4 o; o.x = pk2(s[0 * 33] * g0[0], s[1 * 33] * g0[1]); o.y = pk2(s[2 * 33] * g0[2], s[3 * 33] * g0[3]); o.z = pk2(s[4 * 33] * g1[0], s[5 * 33] * g1[1]); o.w = pk2(s[6 * 33] * g1[2], s[7 * 33] * g1[3]);
            *(u32x4*)(WT + (size_t)drow * K + k0 + 8 * c) = o; } }
    LDS_WAIT();
}
__device__ __forceinline__ void conv_layer(const Ctx& C, int l) {
    LAS float* scr = (LAS float*)(C.lds + __builtin_amdgcn_readfirstlane(C.tid >> 6) * 16384);
    bf16_t* WB = WSP(bf16_t, WS_W0 + (size_t)(l & 1) * WS_WSTRIDE);
    const int gw = C.bid * 8 + __builtin_amdgcn_readfirstlane(C.tid >> 6), NGW = C.G * 8;
    const bool even = (l & 1) == 0; const int sub = l >> 1;
    const int n_in = even ? AB_IN : C_IN;
    const int i0 = 16 * ((n_in + 31) / 32), i1 = 16 * 32, i2 = 16 * 32, i3 = 16 * 64, i4 = 16 * 32, i5 = 16 * 128, i6 = 64 * 32;
    const int tot = i0 + i1 + i2 + i3 + i4 + i5 + i6;
    for (int it = gw; it < tot; it += NGW) {
        int r = it;
        if (r < i0) { tr_item(even ? C.in[7] + (size_t)sub * D * AB_IN : C.in[12] + (size_t)sub * D * C_IN, D, n_in, WB + WO_IN, C.in[2] + l * D, even ? 1 : 0, scr, r, (C.tid & 63), even ? 2048 : 0, even ? 2560 : 1024, 0.125f * LOG2E); continue; } r -= i0;
        if (r < i1) { tr_item(even ? C.in[11] + (size_t)sub * D * D : C.in[14] + (size_t)sub * D * D, D, D, WB + WO_OUT, nullptr, 0, scr, r, (C.tid & 63)); continue; } r -= i1;
        if (r < i2) { tr_item(C.in[15] + (size_t)l * D * D, D, D, WB + WO_XQ, C.in[3] + l * D, 0, scr, r, (C.tid & 63), 0, D, 0.0625f * LOG2E); continue; } r -= i2;
        if (r < i3) { tr_item(C.in[16] + (size_t)l * D * 2 * D, D, 2 * D, WB + WO_XKV, C.in[4] + l * D, 0, scr, r, (C.tid & 63)); continue; } r -= i3;
        if (r < i4) { tr_item(C.in[17] + (size_t)l * D * D, D, D, WB + WO_XO, nullptr, 0, scr, r, (C.tid & 63)); continue; } r -= i4;
        if (r < i5) { tr_item(C.in[18] + (size_t)l * D * FF, D, FF, WB + WO_UP, C.in[5] + l * D, 0, scr, r, (C.tid & 63)); continue; } r -= i5;
        tr_item(C.in[19] + (size_t)l * FF * D, FF, D, WB + WO_DOWN, nullptr, 0, scr, r, (C.tid & 63));
    }
}
__device__ __forceinline__ float row_to_bf16(const float* xrow, bf16_t* orow, int lane) {
    const f32x4* xr = (const f32x4*)xrow + lane; float s = 0.f;
    unsigned long long* o8 = (unsigned long long*)orow + lane;
#pragma unroll
    for (int j = 0; j < 4; ++j) { const f32x4 v = xr[64 * j]; s += (v[0] * v[0] + v[1] * v[1]) + (v[2] * v[2] + v[3] * v[3]);
        o8[64 * j] = (unsigned long long)pk2(v[0], v[1]) | ((unsigned long long)pk2(v[2], v[3]) << 32); }
    return wave_sum(s);
}
__device__ __forceinline__ void prologue(const Ctx& C) {
    conv_layer(C, 0);
    const int gw = C.bid * 8 + __builtin_amdgcn_readfirstlane(C.tid >> 6), NGW = C.G * 8;
    bf16_t* HB = WSP(bf16_t, WS_HB); float* RSS = WSP(float, WS_RSS);
    for (int m = gw; m < T; m += NGW) { const float ss = row_to_bf16(C.in[0] + (size_t)m * D, HB + (size_t)m * D, (C.tid & 63));
        if ((C.tid & 63) < 16) RSS[(size_t)m * 16 + (C.tid & 63)] = (C.tid & 63) == 0 ? ss : 0.f; }
    bf16_t* MB = WSP(bf16_t, WS_MEMB); float* RM = WSP(float, WS_RSTDM);
    for (int m = gw; m < TM; m += NGW) { const float ss = row_to_bf16(C.in[1] + (size_t)m * D, MB + (size_t)m * D, (C.tid & 63));
        if ((C.tid & 63) == 0) RM[m] = rsqrtf(ss * (1.0f / D) + EPS); }
}
__device__ __forceinline__ void final_norm(const Ctx& C) {
    const int gw = C.bid * 8 + __builtin_amdgcn_readfirstlane(C.tid >> 6), NGW = C.G * 8; const float* gn = C.in[6]; const bf16_t* HB = WSP(bf16_t, WS_HB);
    for (int m = gw; m < T; m += NGW) { const u32x2* hr = (const u32x2*)(HB + (size_t)m * D) + (C.tid & 63); f32x4* xr = (f32x4*)(C.out + (size_t)m * D) + (C.tid & 63); f32x4 v[4]; float s = 0.f;
#pragma unroll
        for (int j = 0; j < 4; ++j) { const u32x2 b = hr[64 * j]; v[j] = (f32x4){__uint_as_float(b.x << 16), __uint_as_float(b.x & 0xffff0000u), __uint_as_float(b.y << 16), __uint_as_float(b.y & 0xffff0000u)};
            s += (v[j][0] * v[j][0] + v[j][1] * v[j][1]) + (v[j][2] * v[j][2] + v[j][3] * v[j][3]); }
        const float rstd = rsqrtf(wave_sum(s) * (1.0f / D) + EPS);
#pragma unroll
        for (int j = 0; j < 4; ++j) { const f32x4 g4 = ((const f32x4*)gn)[(C.tid & 63) + 64 * j]; xr[64 * j] = v[j] * rstd * g4; } }
}

__device__ __forceinline__ float log_sigmoid(float x) { return fminf(x, 0.f) - log1pf(__expf(-fabsf(x))); }
__device__ __forceinline__ float sigmoidf_(float x) { return 1.0f / (1.0f + __expf(-x)); }

template <int DH, int MODE>
__device__ __forceinline__ void naive_attn_row(const bf16_t* qrow, const bf16_t* Kb, const bf16_t* Vb, int ldkv, int nk, float scale,
                                               const float* tab, int rel0, const float* cum, int tpos, bf16_t* orow, LAS float* pl, LAS float* ql, int lane) {
#pragma unroll
    for (int j = 0; j < DH / 64; ++j) ql[lane + 64 * j] = bf2f(qrow[lane + 64 * j]);
    LDS_WAIT();
    float mx = -INFINITY;
    for (int k = lane; k < nk; k += 64) {
        const u32x4* kr = (const u32x4*)(Kb + (size_t)k * ldkv); float dot = 0.f;
#pragma unroll 4
        for (int c = 0; c < DH / 8; ++c) { const u32x4 w = kr[c];
#pragma unroll
            for (int e = 0; e < 4; ++e) { dot += ql[c * 8 + 2 * e] * __uint_as_float(w[e] << 16) + ql[c * 8 + 2 * e + 1] * __uint_as_float(w[e] & 0xffff0000u); } }
        float lg = dot * scale;
        if (MODE == 1) { int rel = rel0 - k; rel = rel < -128 ? -128 : (rel > 128 ? 128 : rel); lg += tab[rel + 128]; }
        if (MODE == 2) lg += cum[tpos] - cum[k];
        pl[k] = lg; mx = fmaxf(mx, lg);
    }
    mx = wave_max(mx); float sum = 0.f;
    for (int k = lane; k < nk; k += 64) { const float e = __expf(pl[k] - mx); pl[k] = e; sum += e; }
    sum = wave_sum(sum); LDS_WAIT();
    const float inv = 1.0f / sum;
#pragma unroll
    for (int j = 0; j < DH / 64; ++j) { const int d = lane + 64 * j; float a = 0.f;
        for (int k = 0; k < nk; ++k) a += pl[k] * bf2f(Vb[(size_t)k * ldkv + d]);
        orow[d] = (bf16_t)f2bf(a * inv); }
    LDS_WAIT();
}
__device__ __forceinline__ void naive_band(const Ctx& C, int e) {
    bf16_t* BIG = WSP(bf16_t, WS_BIG); const int gw = C.bid * 8 + __builtin_amdgcn_readfirstlane(C.tid >> 6), NGW = C.G * 8;
    LAS float* pl = (LAS float*)(C.lds + __builtin_amdgcn_readfirstlane(C.tid >> 6) * 9216); LAS float* ql = pl + 2048;
    for (int it = gw; it < T * BH; it += NGW) { const int hd = it % BH, row = it / BH, b = row / SEQ, t = row % SEQ, cq = t / CHUNK;
        const int c0 = cq - 8 < 0 ? 0 : cq - 8, k0 = c0 * CHUNK, nk = (cq + 1) * CHUNK - k0;
        bf16_t* qp = BIG + (size_t)row * AB_IN + COL_QB + hd * BD;
        const bf16_t* kp = BIG + (size_t)(b * SEQ + k0) * AB_IN + COL_KB + hd * BD; const bf16_t* vp = BIG + (size_t)(b * SEQ + k0) * AB_IN + COL_VB + hd * BD;
        naive_attn_row<BD, 1>(qp, kp, vp, AB_IN, nk, 0.125f, C.in[10] + (size_t)(e * BH + hd) * 257, t - k0, nullptr, 0, qp, pl, ql, (C.tid & 63)); }
}
__device__ __forceinline__ void naive_fox_cum(const Ctx& C, int o) {
    const bf16_t* BIG = WSP(bf16_t, WS_BIG); float* cum = WSP(float, WS_FOXC);
    const int g = C.bid * 512 + C.tid;
    if (g < NB * CH) { const int b = g / CH, hd = g % CH; const float fb = C.in[13][o * CH + hd]; float c = 0.f;
        for (int t = 0; t < SEQ; ++t) { c += log_sigmoid(bf2f(BIG[(size_t)(b * SEQ + t) * C_INP + COL_CF + hd]) + fb); cum[(size_t)g * SEQ + t] = c; } }
}
__device__ __forceinline__ void naive_fox(const Ctx& C) {
    bf16_t* BIG = WSP(bf16_t, WS_BIG); const float* cum = WSP(float, WS_FOXC); const int gw = C.bid * 8 + __builtin_amdgcn_readfirstlane(C.tid >> 6), NGW = C.G * 8;
    LAS float* pl = (LAS float*)(C.lds + __builtin_amdgcn_readfirstlane(C.tid >> 6) * 9216); LAS float* ql = pl + 2048;
    for (int it = gw; it < T * CH; it += NGW) { const int hd = it % CH, row = it / CH, b = row / SEQ, t = row % SEQ;
        bf16_t* qp = BIG + (size_t)row * C_INP + COL_CQ + hd * CD;
        const bf16_t* kp = BIG + (size_t)(b * SEQ) * C_INP + COL_CK + hd * CD; const bf16_t* vp = BIG + (size_t)(b * SEQ) * C_INP + COL_CV + hd * CD;
        naive_attn_row<CD, 2>(qp, kp, vp, C_INP, t + 1, 0.125f, nullptr, 0, cum + (size_t)(b * CH + hd) * SEQ, t, qp, pl, ql, (C.tid & 63)); }
}
__device__ __forceinline__ void naive_xattn(const Ctx& C) {
    bf16_t* XQ = WSP(bf16_t, WS_BIG); const bf16_t* KV = WSP(bf16_t, WS_MEMKV); const int gw = C.bid * 8 + __builtin_amdgcn_readfirstlane(C.tid >> 6), NGW = C.G * 8;
    LAS float* pl = (LAS float*)(C.lds + __builtin_amdgcn_readfirstlane(C.tid >> 6) * 9216); LAS float* ql = pl + 2048;
    for (int it = gw; it < T * XH; it += NGW) { const int hd = it % XH, row = it / XH, b = row / SEQ;
        bf16_t* qp = XQ + (size_t)row * D + hd * XD;
        const bf16_t* kp = KV + (size_t)(b * MEMT) * 2 * D + hd * XD; const bf16_t* vp = kp + D;
        naive_attn_row<XD, 0>(qp, kp, vp, 2 * D, MEMT, 0.0625f, nullptr, 0, nullptr, 0, qp, pl, ql, (C.tid & 63)); }
}
__device__ __forceinline__ void naive_hgrn(const Ctx& C, int e) {
    bf16_t* BIG = WSP(bf16_t, WS_BIG);
    LAS float* fL = (LAS float*)C.lds; LAS float* qL = fL + 2048; LAS float* vL = qL + 2048; LAS float* oL = vL + 2048;
    const int dv = C.tid & 127, kq = C.tid >> 7;
    for (int u = C.bid; u < NB * AH; u += C.G) { const int b = u / AH, hd = u % AH;
        float S[32];
#pragma unroll
        for (int i = 0; i < 32; ++i) S[i] = 0.f;
        for (int t0 = 0; t0 < SEQ; t0 += 16) {
            for (int idx = C.tid; idx < 2048; idx += 512) { const int r = idx >> 7, c = idx & 127; const size_t ro = (size_t)(b * SEQ + t0 + r) * AB_IN + hd * AD + c;
                float lb = 0.f; if (e == 1) { const float l0 = C.in[8][hd * AD + c], l1 = C.in[8][512 + hd * AD + c]; lb = 1.0f / (1.0f + __expf(l0 - l1)); }
                const float z = bf2f(BIG[ro + COL_FA]), q = bf2f(BIG[ro + COL_QA]);
                fL[idx] = lb + (1.0f - lb) * sigmoidf_(z); qL[idx] = q * sigmoidf_(q) * 0.08838834764831845f; vL[idx] = bf2f(BIG[ro + COL_IA]); }
            __syncthreads();
#pragma unroll 1
            for (int r = 0; r < 16; ++r) { const float v = vL[r * 128 + dv]; float po = 0.f;
#pragma unroll
                for (int i = 0; i < 32; ++i) { const float f = fL[r * 128 + kq * 32 + i]; S[i] = f * S[i] + (1.0f - f) * v; po += S[i] * qL[r * 128 + kq * 32 + i]; }
                oL[(r * 4 + kq) * 128 + dv] = po; }
            __syncthreads();
#pragma unroll
            for (int rr = 0; rr < 2; ++rr) { const int r = __builtin_amdgcn_readfirstlane(C.tid >> 6) * 2 + rr; float o[2]; float ss = 0.f;
#pragma unroll
                for (int j = 0; j < 2; ++j) { const int d = (C.tid & 63) + 64 * j; o[j] = (oL[(r * 4 + 0) * 128 + d] + oL[(r * 4 + 1) * 128 + d]) + (oL[(r * 4 + 2) * 128 + d] + oL[(r * 4 + 3) * 128 + d]); ss += o[j] * o[j]; }
                const float rstd = rsqrtf(wave_sum(ss) * (1.0f / AD) + EPS);
#pragma unroll
                for (int j = 0; j < 2; ++j) { const int d = (C.tid & 63) + 64 * j; const size_t ro = (size_t)(b * SEQ + t0 + r) * AB_IN + hd * AD + d;
                    const float g = bf2f(BIG[ro + COL_GA]); const float val = o[j] * rstd * C.in[9][e * 512 + hd * AD + d] * (g * sigmoidf_(g));
                    BIG[ro + COL_QA] = (bf16_t)f2bf(val); } }
            __syncthreads();
        }
    }
}

typedef short v4i16_t __attribute__((ext_vector_type(4)));
__device__ __forceinline__ v4i16_t tr_read(const LAS unsigned char* p) { return __builtin_amdgcn_ds_read_tr16_b64_v4i16((LAS v4i16_t*)p); }
typedef float f32x2_t __attribute__((ext_vector_type(2))); typedef __bf16 bf16x2_t __attribute__((ext_vector_type(2)));
__device__ __forceinline__ unsigned cvtpk(float lo, float hi) { f32x2_t v = {lo, hi}; bf16x2_t b = __builtin_convertvector(v, bf16x2_t); return __builtin_bit_cast(unsigned, b); }
__device__ __forceinline__ float max3f(float a, float b, float c) { float r; asm("v_max3_f32 %0, %1, %2, %3" : "=v"(r) : "v"(a), "v"(b), "v"(c)); return r; }
__device__ __forceinline__ int crow(int r, int hi) { return (r & 3) + 8 * (r >> 2) + 4 * hi; }

template <int DH, int MODE, int NSPLIT>
__device__ __forceinline__ void attn_unit(LAS unsigned char* lds, const bf16_t* Qp, int ldq, const bf16_t* Kp, const bf16_t* Vp, int ldkv, bf16_t* Op, int ldo,
                                          int kt0, int kt1, int tq0, float sc2, const LAS float* aux, int tid) {
    constexpr bool DMA = (DH == 256);
    constexpr int KSTR = DMA ? DH * 2 : DH * 2 + 16, KB = 64 * KSTR, VB = 64 * DH * 2, CPR = DH / 8, NCH = DH / 64, ND0 = DH / 32 / NSPLIT, NS = DH / 16, NSUBD = DH / 32;
    const int lane = tid & 63, w = __builtin_amdgcn_readfirstlane(tid >> 6), hi = lane >> 5, l31 = lane & 31;
    const int qg = NSPLIT == 1 ? w : (w & 3), dsel = NSPLIT == 1 ? 0 : (w >> 2);
    const int qloc = qg * 32 + l31, tq = tq0 + qloc;
    bf16x8 qr[NS];
#pragma unroll
    for (int s = 0; s < NS; ++s) qr[s] = *(const bf16x8*)(Qp + (size_t)qloc * ldq + 16 * s + 8 * hi);
    f32x16 o[ND0];
#pragma unroll
    for (int i = 0; i < ND0; ++i)
#pragma unroll
        for (int r = 0; r < 16; ++r) o[i][r] = 0.f;
    float m = -1e30f, l = 0.f;
    const int qfirst = tq0 + qg * 32, cq = qfirst >> 6;
    unsigned kso[NCH], vso[NCH]; size_t gso[NCH];
#pragma unroll
    for (int i = 0; i < NCH; ++i) { const int cidx = tid + 512 * i, row = cidx / CPR, ch = cidx % CPR;
        kso[i] = row * KSTR + ch * 16; vso[i] = ((row >> 3) * NSUBD + (ch >> 2)) * 512 + (row & 7) * 64 + (ch & 3) * 16; gso[i] = (size_t)row * ldkv + ch * 8; }
    const int vlane = (4 * hi + ((lane & 15) >> 2)) * 64 + ((lane >> 4) & 1) * 32 + (lane & 3) * 8;
    constexpr bool PREF = (DH == 64);
    u32x4 kreg[NCH], vreg[NCH];
    unsigned kgo[4], vgo[4];
    if (DMA) {
#pragma unroll
        for (int i = 0; i < 4; ++i) { const int blk = w * 4 + i; { const int row = 2 * blk + (lane >> 5), ch = (lane & 31) ^ (row & 15); kgo[i] = (unsigned)(row * ldkv + ch * 8); }
            { const int sub = 2 * blk + (lane >> 5), within = lane & 31, row = (sub >> 3) * 8 + (within >> 2), ch = (sub & 7) * 4 + (within & 3); vgo[i] = (unsigned)(row * ldkv + ch * 8); } }
    }
#define ATT_DMA_ISSUE(tt, bb) do { _Pragma("unroll") for (int i_ = 0; i_ < 4; ++i_) { \
        __builtin_amdgcn_global_load_lds((const unsigned*)(Kp + (size_t)(tt) * 64 * ldkv + kgo[i_]), (LAS unsigned*)(lds + (bb) * KB + (w * 4 + i_) * 1024), 16, 0, 0); \
        __builtin_amdgcn_global_load_lds((const unsigned*)(Vp + (size_t)(tt) * 64 * ldkv + vgo[i_]), (LAS unsigned*)(lds + 2 * KB + (bb) * VB + (w * 4 + i_) * 1024), 16, 0, 0); } } while (0)
    if (PREF) {
#pragma unroll
        for (int i = 0; i < NCH; ++i) { kreg[i] = *(const u32x4*)(Kp + (size_t)kt0 * 64 * ldkv + gso[i]); vreg[i] = *(const u32x4*)(Vp + (size_t)kt0 * 64 * ldkv + gso[i]); }
#pragma unroll
        for (int i = 0; i < NCH; ++i) { *(LAS u32x4*)(lds + kso[i]) = kreg[i]; *(LAS u32x4*)(lds + 2 * KB + vso[i]) = vreg[i]; }
        __syncthreads();
    }
    if (DMA) ATT_DMA_ISSUE(kt0, 0);
    for (int t = kt0; t < kt1; ++t) {
        const int buf = (t - kt0) & 1;
        if (DMA) {
            asm volatile("s_waitcnt vmcnt(0)" ::: "memory"); __builtin_amdgcn_s_barrier(); asm volatile("" ::: "memory");
            if (t + 1 < kt1) ATT_DMA_ISSUE(t + 1, buf ^ 1);
        }
        if (PREF && t + 1 < kt1) {
#pragma unroll
            for (int i = 0; i < NCH; ++i) { kreg[i] = *(const u32x4*)(Kp + (size_t)(t + 1) * 64 * ldkv + gso[i]); vreg[i] = *(const u32x4*)(Vp + (size_t)(t + 1) * 64 * ldkv + gso[i]); }
        }
        bool active = true, masked = false;
        if (MODE == 1) active = (t >= cq - 8) && (t <= cq);
        if (MODE == 2) { active = (64 * t <= qfirst + 31); masked = (64 * t + 63 > qfirst); }
        if (active) {
            const LAS unsigned char* Kb = lds + buf * KB; const LAS unsigned char* Vb = lds + 2 * KB + buf * VB;
            f32x16 p0, p1;
#pragma unroll
            for (int r = 0; r < 16; ++r) { p0[r] = 0.f; p1[r] = 0.f; }
#pragma unroll
            for (int s = 0; s < NS; ++s) {
                const int kco = DMA ? (((2 * s + hi) ^ (l31 & 15)) * 16) : (16 * s + 8 * hi) * 2;
                const bf16x8 k0 = *(const LAS bf16x8*)(Kb + l31 * KSTR + kco);
                const bf16x8 k1 = *(const LAS bf16x8*)(Kb + (32 + l31) * KSTR + kco);
                p0 = __builtin_amdgcn_mfma_f32_32x32x16_bf16(k0, qr[s], p0, 0, 0, 0);
                p1 = __builtin_amdgcn_mfma_f32_32x32x16_bf16(k1, qr[s], p1, 0, 0, 0);
            }
            if (MODE == 2) {
#pragma unroll
                for (int g = 0; g < 4; ++g) {
                    const f32x4 c0 = *(const LAS f32x4*)(aux + 64 * t + 8 * g + 4 * hi), c1 = *(const LAS f32x4*)(aux + 64 * t + 32 + 8 * g + 4 * hi);
#pragma unroll
                    for (int e = 0; e < 4; ++e) { p0[4 * g + e] -= c0[e]; p1[4 * g + e] -= c1[e]; }
                }
                if (masked) {
#pragma unroll
                    for (int r = 0; r < 16; ++r) { const int kv = 64 * t + crow(r, hi); if (kv > tq) p0[r] = -INFINITY; if (kv + 32 > tq) p1[r] = -INFINITY; }
                }
            } else if (MODE == 1) {
                if (t <= cq - 3) { const float bc = aux[256];
#pragma unroll
                    for (int r = 0; r < 16; ++r) { p0[r] += bc; p1[r] += bc; }
                } else {
#pragma unroll
                    for (int r = 0; r < 16; ++r) { int rel = tq - (64 * t + crow(r, hi)); int i0 = rel > 128 ? 128 : rel, i1 = rel - 32 > 128 ? 128 : rel - 32; i0 = i0 < -128 ? -128 : i0; i1 = i1 < -128 ? -128 : i1;
                        p0[r] += aux[i0 + 128]; p1[r] += aux[i1 + 128]; }
                }
            }
            float mxa = max3f(p0[0], p1[0], p0[1]), mxb = max3f(p1[1], p0[2], p1[2]);
#pragma unroll
            for (int r = 3; r < 15; r += 2) { mxa = max3f(mxa, p0[r], p1[r]); mxb = max3f(mxb, p0[r + 1], p1[r + 1]); }
            mxa = max3f(mxa, p0[15], p1[15]);
            float mx = max3f(mxa, mxb, mxa);
            mx = max3f(mx, __shfl_xor(mx, 32), mx);
            const float mnew = fmaxf(m, mx), alpha = __builtin_amdgcn_exp2f(m - mnew);
            m = mnew; float ls = 0.f;
#pragma unroll
            for (int r = 0; r < 16; ++r) { p0[r] = __builtin_amdgcn_exp2f(p0[r] - mnew); p1[r] = __builtin_amdgcn_exp2f(p1[r] - mnew); ls += p0[r] + p1[r]; }
            l = l * alpha + ls;
#pragma unroll
            for (int i = 0; i < ND0; ++i)
#pragma unroll
                for (int r = 0; r < 16; ++r) o[i][r] *= alpha;
#pragma unroll
            for (int ks = 0; ks < 4; ++ks) {
                u32x4 pw;
                if (ks < 2) { pw.x = cvtpk(p0[8 * ks + 0], p0[8 * ks + 1]); pw.y = cvtpk(p0[8 * ks + 2], p0[8 * ks + 3]); pw.z = cvtpk(p0[8 * ks + 4], p0[8 * ks + 5]); pw.w = cvtpk(p0[8 * ks + 6], p0[8 * ks + 7]); }
                else { const int k2 = ks - 2; pw.x = cvtpk(p1[8 * k2 + 0], p1[8 * k2 + 1]); pw.y = cvtpk(p1[8 * k2 + 2], p1[8 * k2 + 3]); pw.z = cvtpk(p1[8 * k2 + 4], p1[8 * k2 + 5]); pw.w = cvtpk(p1[8 * k2 + 6], p1[8 * k2 + 7]); }
                const bf16x8 pf = __builtin_bit_cast(bf16x8, pw);
#pragma unroll
                for (int i = 0; i < ND0; ++i) { const int d0 = dsel * ND0 + i;
                    const v4i16_t lo = tr_read(Vb + ((2 * ks) * NSUBD + d0) * 512 + vlane), h4 = tr_read(Vb + ((2 * ks + 1) * NSUBD + d0) * 512 + vlane);
                    const bf16x8 vf = (bf16x8){lo[0], lo[1], lo[2], lo[3], h4[0], h4[1], h4[2], h4[3]};
                    o[i] = __builtin_amdgcn_mfma_f32_32x32x16_bf16(vf, pf, o[i], 0, 0, 0); }
            }
        }
        if (PREF) {
            if (t + 1 < kt1) {
#pragma unroll
                for (int i = 0; i < NCH; ++i) { *(LAS u32x4*)(lds + (buf ^ 1) * KB + kso[i]) = kreg[i]; *(LAS u32x4*)(lds + 2 * KB + (buf ^ 1) * VB + vso[i]) = vreg[i]; }
            }
            __syncthreads();
        }
    }
#undef ATT_DMA_ISSUE
    l += __shfl_xor(l, 32);
    const float inv = 1.0f / l;
#pragma unroll
    for (int i = 0; i < ND0; ++i)
#pragma unroll
        for (int g = 0; g < 4; ++g) { u32x2 wv; wv.x = cvtpk(o[i][4 * g] * inv, o[i][4 * g + 1] * inv); wv.y = cvtpk(o[i][4 * g + 2] * inv, o[i][4 * g + 3] * inv);
            *(u32x2*)(Op + (size_t)qloc * ldo + (dsel * ND0 + i) * 32 + 8 * g + 4 * hi) = wv; }
}

constexpr int A64_STG = 16384;
template <int MODE>
__device__ __forceinline__ void attn64_dma(LAS unsigned char* lds, const bf16_t* Qp, int ldq, const bf16_t* Kp, const bf16_t* Vp, int ldkv, bf16_t* Op, int ldo,
                                           int kt0, int kt1, int tq0, const LAS float* aux, int tid) {
    const int lane = tid & 63, w = __builtin_amdgcn_readfirstlane(tid >> 6), hi = lane >> 5, l31 = lane & 31;
    const int qloc = w * 32 + l31, tq = tq0 + qloc;
    bf16x8 qr[4];
#pragma unroll
    for (int s = 0; s < 4; ++s) qr[s] = *(const bf16x8*)(Qp + (size_t)qloc * ldq + 16 * s + 8 * hi);
    f32x16 o[2];
#pragma unroll
    for (int i = 0; i < 2; ++i)
#pragma unroll
        for (int r = 0; r < 16; ++r) o[i][r] = 0.f;
    float m = -1e30f, l = 0.f;
    const int qfirst = tq0 + w * 32, cq = qfirst >> 6;
    const int vlane = (4 * hi + ((lane & 15) >> 2)) * 64 + ((lane >> 4) & 1) * 32 + (lane & 3) * 8;
    unsigned kgo, vgo;
    { const int row = 8 * w + (lane >> 3), ch = (lane & 7) ^ ((row >> 1) & 7); kgo = (unsigned)(row * ldkv + ch * 8); }
    { const int sub = 2 * w + (lane >> 5), within = lane & 31, row = (sub >> 1) * 8 + (within >> 2), ch = (sub & 1) * 4 + (within & 3); vgo = (unsigned)(row * ldkv + ch * 8); }
    const int krd0 = l31 * 128, krd1 = (32 + l31) * 128, ksw = (l31 >> 1) & 7;
#define A64_ISSUE(tt) do { const int st_ = ((tt) - kt0) & 3; \
        __builtin_amdgcn_global_load_lds((const unsigned*)(Kp + (size_t)(tt) * 64 * ldkv + kgo), (LAS unsigned*)(lds + st_ * A64_STG + w * 1024), 16, 0, 0); \
        __builtin_amdgcn_global_load_lds((const unsigned*)(Vp + (size_t)(tt) * 64 * ldkv + vgo), (LAS unsigned*)(lds + st_ * A64_STG + 8192 + w * 1024), 16, 0, 0); } while (0)
    A64_ISSUE(kt0); if (kt0 + 1 < kt1) A64_ISSUE(kt0 + 1);
    for (int tp = kt0; tp < kt1; tp += 2) {
        asm volatile("s_waitcnt vmcnt(0)" ::: "memory");
        __builtin_amdgcn_s_barrier(); asm volatile("" ::: "memory");
        if (tp + 2 < kt1) A64_ISSUE(tp + 2);
        if (tp + 3 < kt1) A64_ISSUE(tp + 3);
#pragma unroll
      for (int jj = 0; jj < 2; ++jj) { const int t = tp + jj; if (t < kt1) {
        bool active = true, masked = false;
        if (MODE == 1) active = (t >= cq - 8) && (t <= cq);
        if (MODE == 2) { active = (64 * t <= qfirst + 31); masked = (64 * t + 63 > qfirst); }
        if (active) {
            const LAS unsigned char* Kb = lds + ((t - kt0) & 3) * A64_STG; const LAS unsigned char* Vb = Kb + 8192;
            f32x16 p0, p1;
#pragma unroll
            for (int r = 0; r < 16; ++r) { p0[r] = 0.f; p1[r] = 0.f; }
#pragma unroll
            for (int s = 0; s < 4; ++s) { const int kco = ((2 * s + hi) ^ ksw) * 16;
                const bf16x8 k0 = *(const LAS bf16x8*)(Kb + krd0 + kco), k1 = *(const LAS bf16x8*)(Kb + krd1 + kco);
                p0 = __builtin_amdgcn_mfma_f32_32x32x16_bf16(k0, qr[s], p0, 0, 0, 0); p1 = __builtin_amdgcn_mfma_f32_32x32x16_bf16(k1, qr[s], p1, 0, 0, 0); }
            if (MODE == 2) {
#pragma unroll
                for (int g = 0; g < 4; ++g) {
                    const f32x4 c0 = *(const LAS f32x4*)(aux + 64 * t + 8 * g + 4 * hi), c1 = *(const LAS f32x4*)(aux + 64 * t + 32 + 8 * g + 4 * hi);
#pragma unroll
                    for (int e = 0; e < 4; ++e) { p0[4 * g + e] -= c0[e]; p1[4 * g + e] -= c1[e]; }
                }
                if (masked) {
#pragma unroll
                    for (int r = 0; r < 16; ++r) { const int kv = 64 * t + crow(r, hi); if (kv > tq) p0[r] = -INFINITY; if (kv + 32 > tq) p1[r] = -INFINITY; }
                }
            } else {
                if (t <= cq - 3) { const float bc = aux[256];
#pragma unroll
                    for (int r = 0; r < 16; ++r) { p0[r] += bc; p1[r] += bc; }
                } else {
#pragma unroll
                    for (int r = 0; r < 16; ++r) { int rel = tq - (64 * t + crow(r, hi)); int i0 = rel > 128 ? 128 : rel, i1 = rel - 32 > 128 ? 128 : rel - 32; i0 = i0 < -128 ? -128 : i0; i1 = i1 < -128 ? -128 : i1;
                        p0[r] += aux[i0 + 128]; p1[r] += aux[i1 + 128]; }
                }
            }
            float mxa = max3f(p0[0], p1[0], p0[1]), mxb = max3f(p1[1], p0[2], p1[2]);
#pragma unroll
            for (int r = 3; r < 15; r += 2) { mxa = max3f(mxa, p0[r], p1[r]); mxb = max3f(mxb, p0[r + 1], p1[r + 1]); }
            mxa = max3f(mxa, p0[15], p1[15]);
            float mx = max3f(mxa, mxb, mxa);
            mx = max3f(mx, __shfl_xor(mx, 32), mx);
            const float mnew = fmaxf(m, mx), alpha = __builtin_amdgcn_exp2f(m - mnew);
            m = mnew; float ls = 0.f;
#pragma unroll
            for (int r = 0; r < 16; ++r) { p0[r] = __builtin_amdgcn_exp2f(p0[r] - mnew); p1[r] = __builtin_amdgcn_exp2f(p1[r] - mnew); ls += p0[r] + p1[r]; }
            l = l * alpha + ls;
#pragma unroll
            for (int i = 0; i < 2; ++i)
#pragma unroll
                for (int r = 0; r < 16; ++r) o[i][r] *= alpha;
#pragma unroll
            for (int ks = 0; ks < 4; ++ks) {
                u32x4 pw;
                if (ks < 2) { pw.x = cvtpk(p0[8 * ks + 0], p0[8 * ks + 1]); pw.y = cvtpk(p0[8 * ks + 2], p0[8 * ks + 3]); pw.z = cvtpk(p0[8 * ks + 4], p0[8 * ks + 5]); pw.w = cvtpk(p0[8 * ks + 6], p0[8 * ks + 7]); }
                else { const int k2 = ks - 2; pw.x = cvtpk(p1[8 * k2 + 0], p1[8 * k2 + 1]); pw.y = cvtpk(p1[8 * k2 + 2], p1[8 * k2 + 3]); pw.z = cvtpk(p1[8 * k2 + 4], p1[8 * k2 + 5]); pw.w = cvtpk(p1[8 * k2 + 6], p1[8 * k2 + 7]); }
                const bf16x8 pf = __builtin_bit_cast(bf16x8, pw);
#pragma unroll
                for (int d0 = 0; d0 < 2; ++d0) {
                    const v4i16_t lo = tr_read(Vb + ((2 * ks) * 2 + d0) * 512 + vlane), h4 = tr_read(Vb + ((2 * ks + 1) * 2 + d0) * 512 + vlane);
                    const bf16x8 vf = (bf16x8){lo[0], lo[1], lo[2], lo[3], h4[0], h4[1], h4[2], h4[3]};
                    o[d0] = __builtin_amdgcn_mfma_f32_32x32x16_bf16(vf, pf, o[d0], 0, 0, 0); }
            }
        }
      } }
    }
#undef A64_ISSUE
    l += __shfl_xor(l, 32);
    const float inv = 1.0f / l;
#pragma unroll
    for (int i = 0; i < 2; ++i)
#pragma unroll
        for (int g = 0; g < 4; ++g) { u32x2 wv; wv.x = cvtpk(o[i][4 * g] * inv, o[i][4 * g + 1] * inv); wv.y = cvtpk(o[i][4 * g + 2] * inv, o[i][4 * g + 3] * inv);
            *(u32x2*)(Op + (size_t)qloc * ldo + i * 32 + 8 * g + 4 * hi) = wv; }
    __syncthreads();
}

constexpr int ATT64_AUX = 4 * A64_STG;
__device__ __forceinline__ void fox_phase(const Ctx& C, int oidx, bool dry) {
    bf16_t* BIG = WSP(bf16_t, WS_BIG);
    LAS float* cl = (LAS float*)(C.lds + ATT64_AUX); LAS float* wtot = cl + SEQ;
    int cur_bh = -1;
    for (int u = C.bid; u < NB * CH * 8; u += C.G) { const int bh = u & 255, qb = u >> 8, b = bh >> 4, hd = bh & 15;
        if (bh != cur_bh) { cur_bh = bh;
            const float fb = C.in[13][oidx * CH + hd]; float s[4]; float run = 0.f;
#pragma unroll
            for (int j = 0; j < 4; ++j) { run += log_sigmoid(bf2f(BIG[(size_t)(b * SEQ + 4 * C.tid + j) * C_INP + COL_CF + hd]) + fb); s[j] = run; }
            float x = run;
#pragma unroll
            for (int off = 1; off < 64; off <<= 1) { const float n = __shfl_up(x, off); if ((C.tid & 63) >= off) x += n; }
            __syncthreads();
            if ((C.tid & 63) == 63) wtot[__builtin_amdgcn_readfirstlane(C.tid >> 6)] = x;
            __syncthreads();
            float pre = 0.f;
            for (int ww = 0; ww < __builtin_amdgcn_readfirstlane(C.tid >> 6); ++ww) pre += wtot[ww];
            const float ex = x - run + pre;
#pragma unroll
            for (int j = 0; j < 4; ++j) cl[4 * C.tid + j] = (ex + s[j]) * LOG2E;
            __syncthreads();
        }
        bf16_t* qp = BIG + (size_t)(b * SEQ + qb * 256) * C_INP + COL_CQ + hd * CD;
        bf16_t* op = dry ? WSP(bf16_t, WS_HG) + (size_t)(b * SEQ + qb * 256) * 1024 + hd * CD : qp;
        attn64_dma<2>(C.lds, qp, C_INP, BIG + (size_t)(b * SEQ) * C_INP + COL_CK + hd * CD, BIG + (size_t)(b * SEQ) * C_INP + COL_CV + hd * CD, C_INP, op, dry ? 1024 : C_INP,
                            0, 4 * qb + 4, qb * 256, cl, C.tid);
    }
}
__device__ __forceinline__ void band_phase(const Ctx& C, int e, bool dry) {
    bf16_t* BIG = WSP(bf16_t, WS_BIG);
    LAS float* tabL = (LAS float*)(C.lds + ATT64_AUX);
    for (int u = C.bid; u < NB * BH * 8; u += C.G) { const int i = u >> 8, v = u & 255; int g, hd, b;
        if (C.G == 256) { const int x = v & 7, jj = (v >> 3) + 32 * i, bhd = x * 16 + (jj >> 3); g = ((jj & 7) + 2 * i) & 7; b = bhd >> 3; hd = bhd & 7; }
        else { g = ((v & 7) + 2 * i) & 7; hd = (v >> 3) & 7; b = (v >> 6) + 4 * i; }
        __syncthreads();
        if (C.tid < 257) tabL[C.tid] = C.in[10][(size_t)(e * BH + hd) * 257 + C.tid] * LOG2E;
        __syncthreads();
        bf16_t* qp = BIG + (size_t)(b * SEQ + g * 256) * AB_IN + COL_QB + hd * BD;
        bf16_t* op = dry ? BIG + (size_t)T * AB_IN + (size_t)(b * SEQ + g * 256) * 512 + hd * BD : qp;
        attn64_dma<1>(C.lds, qp, AB_IN, BIG + (size_t)(b * SEQ) * AB_IN + COL_KB + hd * BD, BIG + (size_t)(b * SEQ) * AB_IN + COL_VB + hd * BD, AB_IN, op, dry ? 512 : AB_IN,
                            4 * g - 8 < 0 ? 0 : 4 * g - 8, 4 * g + 4, g * 256, tabL, C.tid);
    }
}
__device__ __forceinline__ void xattn_unit2(LAS unsigned char* lds, const bf16_t* Qp, const bf16_t* Kp, const bf16_t* Vp, bf16_t* Op, int tid) {
    constexpr int SLOT = 32768, LDQ = D, LDKV = 2 * D;
    const int lane = tid & 63, w = __builtin_amdgcn_readfirstlane(tid >> 6), hi = lane >> 5, l31 = lane & 31, qloc = w * 32 + l31;
    const int vlane = (4 * hi + ((lane & 15) >> 2)) * 64 + ((lane >> 4) & 1) * 32 + (lane & 3) * 8;
#define XA_ISSUE(idx) do { const bf16_t* src_ = ((idx) < 8 ? Kp : Vp) + (size_t)((idx) & 3) * 64 * LDKV; _Pragma("unroll") for (int i_ = 0; i_ < 4; ++i_) { const int blk_ = w * 4 + i_; unsigned go_; \
        if ((idx) < 8) { const int row_ = 2 * blk_ + (lane >> 5), ch_ = (lane & 31) ^ (row_ & 15); go_ = (unsigned)(row_ * LDKV + ch_ * 8); } \
        else { const int sub_ = 2 * blk_ + (lane >> 5), within_ = lane & 31, row_ = (sub_ >> 3) * 8 + (within_ >> 2), ch_ = (sub_ & 7) * 4 + (within_ & 3); go_ = (unsigned)(row_ * LDKV + ch_ * 8); } \
        __builtin_amdgcn_global_load_lds((const unsigned*)(src_ + go_), (LAS unsigned*)(lds + ((idx) & 3) * SLOT + blk_ * 1024), 16, 0, 0); } } while (0)
#define XA_WAIT(n) asm volatile("s_waitcnt vmcnt(" #n ")" ::: "memory")
#define XA_BAR() do { __builtin_amdgcn_s_barrier(); asm volatile("" ::: "memory"); } while (0)
    XA_ISSUE(0); XA_ISSUE(1); XA_ISSUE(2);
    f32x16 S[8];
#pragma unroll
    for (int j = 0; j < 8; ++j)
#pragma unroll
        for (int r = 0; r < 16; ++r) S[j][r] = 0.f;
#pragma unroll
    for (int pass = 0; pass < 2; ++pass) {
        bf16x8 qr[8];
#pragma unroll
        for (int s = 0; s < 8; ++s) qr[s] = *(const bf16x8*)(Qp + (size_t)qloc * LDQ + 16 * (8 * pass + s) + 8 * hi);
#pragma unroll
        for (int i = 0; i < 4; ++i) {
            XA_WAIT(8); XA_BAR();
            XA_ISSUE(4 * pass + i + 3);
            const LAS unsigned char* Kb = lds + i * SLOT;
#pragma unroll
            for (int ss = 0; ss < 8; ++ss) { const int s = 8 * pass + ss; const int kco = ((2 * s + hi) ^ (l31 & 15)) * 16;
                const bf16x8 k0 = *(const LAS bf16x8*)(Kb + l31 * 512 + kco), k1 = *(const LAS bf16x8*)(Kb + (32 + l31) * 512 + kco);
                S[2 * i] = __builtin_amdgcn_mfma_f32_32x32x16_bf16(k0, qr[ss], S[2 * i], 0, 0, 0); S[2 * i + 1] = __builtin_amdgcn_mfma_f32_32x32x16_bf16(k1, qr[ss], S[2 * i + 1], 0, 0, 0); }
            __builtin_amdgcn_sched_barrier(0);
        }
    }
    float mx = S[0][0];
#pragma unroll
    for (int j = 0; j < 8; ++j)
#pragma unroll
        for (int r = 0; r < 16; ++r) mx = fmaxf(mx, S[j][r]);
    mx = fmaxf(mx, __shfl_xor(mx, 32));
    float l = 0.f; u32x4 pw[16];
#pragma unroll
    for (int j = 0; j < 8; ++j) {
#pragma unroll
        for (int r = 0; r < 16; ++r) { S[j][r] = __builtin_amdgcn_exp2f(S[j][r] - mx); l += S[j][r]; }
#pragma unroll
        for (int k2 = 0; k2 < 2; ++k2) { u32x4 t4; t4.x = cvtpk(S[j][8 * k2 + 0], S[j][8 * k2 + 1]); t4.y = cvtpk(S[j][8 * k2 + 2], S[j][8 * k2 + 3]); t4.z = cvtpk(S[j][8 * k2 + 4], S[j][8 * k2 + 5]); t4.w = cvtpk(S[j][8 * k2 + 6], S[j][8 * k2 + 7]); pw[2 * j + k2] = t4; }
        __builtin_amdgcn_sched_barrier(0);
    }
    l += __shfl_xor(l, 32);
    const float inv = 1.0f / l;
    f32x16 o[8];
#pragma unroll
    for (int i = 0; i < 8; ++i)
#pragma unroll
        for (int r = 0; r < 16; ++r) o[i][r] = 0.f;
#pragma unroll
    for (int t = 0; t < 4; ++t) {
        if (t < 2) XA_WAIT(8); else if (t == 2) XA_WAIT(4); else XA_WAIT(0);
        XA_BAR();
        if (t == 0) XA_ISSUE(11);
        const LAS unsigned char* Vb = lds + t * SLOT;
#pragma unroll
        for (int ks = 0; ks < 4; ++ks) { const bf16x8 pf = __builtin_bit_cast(bf16x8, pw[4 * t + ks]);
#pragma unroll
            for (int d0 = 0; d0 < 8; ++d0) {
                const v4i16_t lo = tr_read(Vb + ((2 * ks) * 8 + d0) * 512 + vlane), h4 = tr_read(Vb + ((2 * ks + 1) * 8 + d0) * 512 + vlane);
                const bf16x8 vf = (bf16x8){lo[0], lo[1], lo[2], lo[3], h4[0], h4[1], h4[2], h4[3]};
                o[d0] = __builtin_amdgcn_mfma_f32_32x32x16_bf16(vf, pf, o[d0], 0, 0, 0);
                if ((d0 & 1) == 1) __builtin_amdgcn_sched_barrier(0); } }
    }
#pragma unroll
    for (int i = 0; i < 8; ++i)
#pragma unroll
        for (int g = 0; g < 4; ++g) { u32x2 wv; wv.x = cvtpk(o[i][4 * g] * inv, o[i][4 * g + 1] * inv); wv.y = cvtpk(o[i][4 * g + 2] * inv, o[i][4 * g + 3] * inv);
            *(u32x2*)(Op + (size_t)qloc * LDQ + i * 32 + 8 * g + 4 * hi) = wv; }
#undef XA_ISSUE
#undef XA_WAIT
#undef XA_BAR
}
__device__ __forceinline__ void xattn_phase(const Ctx& C, bool dry) {
    bf16_t* XQ = WSP(bf16_t, WS_BIG); const bf16_t* KV = WSP(bf16_t, WS_MEMKV);
    for (int u = C.bid; u < NB * XH * 8; u += C.G) { int qblk, hd, b;
        if (C.G == 256) { const int i = u >> 8, v = u & 255, x = v & 7, jj = (v >> 3) + 32 * i, bhd = x * 8 + (jj >> 3); qblk = jj & 7; b = bhd >> 2; hd = bhd & 3; }
        else { qblk = u & 7; hd = (u >> 3) & 3; b = u >> 5; }
        bf16_t* qp = XQ + (size_t)(b * SEQ + qblk * 256) * D + hd * XD;
        const bf16_t* kp = KV + (size_t)(b * MEMT) * 2 * D + hd * XD;
        bf16_t* op = dry ? qp + (size_t)T * D : qp;
        xattn_unit2(C.lds, qp, kp, kp + D, op, C.tid);
    }
}

constexpr int HG_QP = 0, HG_KP = 17408, HG_KE = 34816, HG_V = 51200, HG_GS = 67584;
__device__ __forceinline__ float fast_sigmoid(float x) { return __builtin_amdgcn_rcpf(1.0f + __builtin_amdgcn_exp2f(-x * LOG2E)); }
__device__ __forceinline__ void hgrn_pass1(const Ctx& C, int e) {
    bf16_t* BIG = WSP(bf16_t, WS_BIG); bf16_t* HG = WSP(bf16_t, WS_HG); bf16_t* AM = WSP(bf16_t, WS_AMAT); float* DEC = WSP(float, WS_DEC);
    LAS unsigned char* L = C.lds; LAS float* gs = (LAS float*)(L + HG_GS);
    const int cp = C.tid & 63, rg = C.tid >> 6, lane = (C.tid & 63), w = __builtin_amdgcn_readfirstlane(C.tid >> 6), hi = lane >> 5, l31 = lane & 31;
    const int vlane = (4 * hi + ((lane & 15) >> 2)) * 64 + ((lane >> 4) & 1) * 32 + (lane & 3) * 8;
    unsigned zr[8], qr8[8], vr[8];
    { const int item = C.bid; if (item < NB * AH * 32) { const int n = item & 31, hd = (item >> 5) & 3, b = item >> 7; const bf16_t* p = BIG + ((size_t)b * SEQ + n * 64 + 8 * rg) * AB_IN + hd * AD + 2 * cp;
#pragma unroll
        for (int r = 0; r < 8; ++r) { zr[r] = *(const unsigned*)(p + (size_t)r * AB_IN + COL_FA); qr8[r] = *(const unsigned*)(p + (size_t)r * AB_IN + COL_QA); vr[r] = *(const unsigned*)(p + (size_t)r * AB_IN + COL_IA); } } }
    for (int item = C.bid; item < NB * AH * 32; item += C.G) { const int n = item & 31, hd = (item >> 5) & 3, b = item >> 7; const size_t tok0 = (size_t)b * SEQ + n * 64;
        float lb[2] = {0.f, 0.f};
        if (e == 1) {
#pragma unroll
            for (int j = 0; j < 2; ++j) { const float l0 = C.in[8][hd * AD + 2 * cp + j], l1 = C.in[8][512 + hd * AD + 2 * cp + j]; lb[j] = 1.0f / (1.0f + __expf(l0 - l1)); } }
        bf16_t* p = BIG + (tok0 + 8 * rg) * AB_IN + hd * AD + 2 * cp;
        float bl[8][2], kk[8][2], qs[8][2]; float run[2] = {0.f, 0.f};
#pragma unroll
        for (int r = 0; r < 8; ++r)
#pragma unroll
            for (int j = 0; j < 2; ++j) { const float z = fmaxf(j ? __uint_as_float(zr[r] & 0xffff0000u) : __uint_as_float(zr[r] << 16), -60.f), q = j ? __uint_as_float(qr8[r] & 0xffff0000u) : __uint_as_float(qr8[r] << 16);
                const float sg = fast_sigmoid(z), f = lb[j] + (1.0f - lb[j]) * sg; kk[r][j] = (1.0f - lb[j]) * (1.0f - sg);
                run[j] += __builtin_amdgcn_logf(f); bl[r][j] = run[j]; qs[r][j] = q * fast_sigmoid(q) * 0.08838834764831845f; }
        unsigned vkeep[8];
#pragma unroll
        for (int r = 0; r < 8; ++r) vkeep[r] = vr[r];
        *(LAS float*)(gs + rg * 128 + 2 * cp) = run[0]; *(LAS float*)(gs + rg * 128 + 2 * cp + 1) = run[1];
        __syncthreads();
        float base[2] = {0.f, 0.f}, blast[2] = {0.f, 0.f}, bmid[2] = {0.f, 0.f};
#pragma unroll
        for (int i = 0; i < 8; ++i)
#pragma unroll
            for (int j = 0; j < 2; ++j) { const float g = gs[i * 128 + 2 * cp + j]; if (i < rg) base[j] += g; if (i < 4) bmid[j] += g; blast[j] += g; }
#pragma unroll
        for (int r = 0; r < 8; ++r) { const int row = 8 * rg + r; float qp[2], kp[2], ke[2], qi[2];
#pragma unroll
            for (int j = 0; j < 2; ++j) { const float br = base[j] + bl[r][j]; float ep = br - bmid[j]; ep = ep > 110.f ? 110.f : (ep < -110.f ? -110.f : ep);
                qp[j] = qs[r][j] * __builtin_amdgcn_exp2f(ep); kp[j] = kk[r][j] * __builtin_amdgcn_exp2f(-ep); ke[j] = kk[r][j] * __builtin_amdgcn_exp2f(blast[j] - br); qi[j] = qs[r][j] * __builtin_amdgcn_exp2f(br); }
            *(LAS unsigned*)(L + HG_QP + row * 272 + cp * 4) = cvtpk(qp[0], qp[1]);
            *(LAS unsigned*)(L + HG_KP + row * 272 + cp * 4) = cvtpk(kp[0], kp[1]);
            const int so = ((row >> 3) * 4 + (cp >> 4)) * 512 + (row & 7) * 64 + (cp & 15) * 4;
            *(LAS unsigned*)(L + HG_KE + so) = cvtpk(ke[0], ke[1]);
            *(LAS unsigned*)(L + HG_V + so) = vkeep[r];
            *(unsigned*)(p + (size_t)r * AB_IN + COL_QA) = cvtpk(qi[0], qi[1]); }
        if (rg == 0) { DEC[(size_t)item * 128 + 2 * cp] = __builtin_amdgcn_exp2f(blast[0]); DEC[(size_t)item * 128 + 2 * cp + 1] = __builtin_amdgcn_exp2f(blast[1]); }
        __syncthreads();
        { const int nitem = item + C.G; if (nitem < NB * AH * 32) { const int n2 = nitem & 31, hd2 = (nitem >> 5) & 3, b2 = nitem >> 7; const bf16_t* p2 = BIG + ((size_t)b2 * SEQ + n2 * 64 + 8 * rg) * AB_IN + hd2 * AD + 2 * cp;
#pragma unroll
            for (int r = 0; r < 8; ++r) { zr[r] = *(const unsigned*)(p2 + (size_t)r * AB_IN + COL_FA); qr8[r] = *(const unsigned*)(p2 + (size_t)r * AB_IN + COL_QA); vr[r] = *(const unsigned*)(p2 + (size_t)r * AB_IN + COL_IA); } } }
        if (w < 4) { const int tb = w >> 1, sb = w & 1; f32x16 acc;
#pragma unroll
            for (int r = 0; r < 16; ++r) acc[r] = 0.f;
#pragma unroll
            for (int s = 0; s < 8; ++s) { const bf16x8 qf = *(const LAS bf16x8*)(L + HG_QP + (32 * tb + l31) * 272 + (16 * s + 8 * hi) * 2);
                const bf16x8 kf = *(const LAS bf16x8*)(L + HG_KP + (32 * sb + l31) * 272 + (16 * s + 8 * hi) * 2);
                acc = __builtin_amdgcn_mfma_f32_32x32x16_bf16(kf, qf, acc, 0, 0, 0); }
            bf16_t* ao = AM + (size_t)item * 4096 + (32 * tb + l31) * 64 + 32 * sb + 4 * hi; const int t = 32 * tb + l31;
#pragma unroll
            for (int g = 0; g < 4; ++g) { const int s0 = 32 * sb + 8 * g + 4 * hi; u32x2 wv;
                wv.x = cvtpk(s0 <= t ? acc[4 * g] : 0.f, s0 + 1 <= t ? acc[4 * g + 1] : 0.f); wv.y = cvtpk(s0 + 2 <= t ? acc[4 * g + 2] : 0.f, s0 + 3 <= t ? acc[4 * g + 3] : 0.f);
                *(u32x2*)(ao + 8 * g) = wv; }
        }
#pragma unroll
        for (int jj = 0; jj < 2; ++jj) { const int j = 2 * w + jj, db = j >> 2, cb = j & 3; f32x16 acc;
#pragma unroll
            for (int r = 0; r < 16; ++r) acc[r] = 0.f;
#pragma unroll
            for (int ks = 0; ks < 4; ++ks) {
                const v4i16_t v0 = tr_read(L + HG_V + ((2 * ks) * 4 + db) * 512 + vlane), v1 = tr_read(L + HG_V + ((2 * ks + 1) * 4 + db) * 512 + vlane);
                const v4i16_t k0 = tr_read(L + HG_KE + ((2 * ks) * 4 + cb) * 512 + vlane), k1 = tr_read(L + HG_KE + ((2 * ks + 1) * 4 + cb) * 512 + vlane);
                const bf16x8 vf = (bf16x8){v0[0], v0[1], v0[2], v0[3], v1[0], v1[1], v1[2], v1[3]}, kf = (bf16x8){k0[0], k0[1], k0[2], k0[3], k1[0], k1[1], k1[2], k1[3]};
                acc = __builtin_amdgcn_mfma_f32_32x32x16_bf16(kf, vf, acc, 0, 0, 0); }
            bf16_t* ho = HG + (size_t)item * 16384 + (32 * db + l31) * 128 + 32 * cb + 4 * hi;
#pragma unroll
            for (int g = 0; g < 4; ++g) { u32x2 wv; wv.x = cvtpk(acc[4 * g], acc[4 * g + 1]); wv.y = cvtpk(acc[4 * g + 2], acc[4 * g + 3]); *(u32x2*)(ho + 8 * g) = wv; }
        }
        __syncthreads();
    }
}
__device__ __forceinline__ void hgrn_scan(const Ctx& C) {
    bf16_t* HG = WSP(bf16_t, WS_HG); const float* DEC = WSP(float, WS_DEC);
    for (int gid = C.bid * 512 + C.tid; gid < NB * AH * 2048; gid += C.G * 512) { const int bhd = gid >> 11, e8 = gid & 2047, dv = e8 >> 4, c8 = (e8 & 15) * 8;
        float st[8];
#pragma unroll
        for (int i = 0; i < 8; ++i) st[i] = 0.f;
#pragma unroll 4
        for (int n = 0; n < 32; ++n) { const size_t item = (size_t)bhd * 32 + n; u32x4* hp = (u32x4*)(HG + item * 16384 + dv * 128 + c8); const f32x4* dp = (const f32x4*)(DEC + item * 128 + c8);
            const u32x4 up = *hp; const f32x4 d0 = dp[0], d1 = dp[1];
            u32x4 o; o.x = pk2(st[0], st[1]); o.y = pk2(st[2], st[3]); o.z = pk2(st[4], st[5]); o.w = pk2(st[6], st[7]); *hp = o;
#pragma unroll
            for (int i = 0; i < 4; ++i) { const float ulo = __uint_as_float(up[i] << 16), uhi = __uint_as_float(up[i] & 0xffff0000u); const float da = i < 2 ? d0[2 * i] : d1[2 * i - 4], db2 = i < 2 ? d0[2 * i + 1] : d1[2 * i - 3];
                st[2 * i] = da * st[2 * i] + ulo; st[2 * i + 1] = db2 * st[2 * i + 1] + uhi; } }
    }
}
__device__ __forceinline__ void hgrn_pass3(const Ctx& C, int e) {
    bf16_t* BIG = WSP(bf16_t, WS_BIG); const bf16_t* HG = WSP(bf16_t, WS_HG); const bf16_t* AM = WSP(bf16_t, WS_AMAT);
    LAS unsigned char* L = C.lds; LAS float* ssum = (LAS float*)(L + 16384);
    const int lane = (C.tid & 63), w = __builtin_amdgcn_readfirstlane(C.tid >> 6), hi = lane >> 5, l31 = lane & 31, db = w >> 1, tb = w & 1;
    const int vlane = (4 * hi + ((lane & 15) >> 2)) * 64 + ((lane >> 4) & 1) * 32 + (lane & 3) * 8;
    u32x4 vst[2]; bf16x8 sf[8], qf[8]; u32x2 a0[4], a1[4], gv[4]; f32x4 gn[4];
#define P3_LOAD(it_) do { const int n_ = (it_) & 31, hd_ = ((it_) >> 5) & 3, b_ = (it_) >> 7; const size_t tok_ = (size_t)b_ * SEQ + n_ * 64; \
        _Pragma("unroll") for (int i_ = 0; i_ < 2; ++i_) { const int cidx_ = C.tid + 512 * i_, row_ = cidx_ >> 4, ch_ = cidx_ & 15; vst[i_] = *(const u32x4*)(BIG + (tok_ + row_) * AB_IN + COL_IA + hd_ * AD + ch_ * 8); } \
        const bf16_t* sp_ = HG + (size_t)(it_) * 16384 + (32 * db + l31) * 128 + 8 * hi; const bf16_t* qrow_ = BIG + (tok_ + 32 * tb + l31) * AB_IN + hd_ * AD; \
        const bf16_t* ap_ = AM + (size_t)(it_) * 4096 + (32 * tb + l31) * 64 + 4 * hi; \
        _Pragma("unroll") for (int s_ = 0; s_ < 8; ++s_) { sf[s_] = *(const bf16x8*)(sp_ + 16 * s_); qf[s_] = *(const bf16x8*)(qrow_ + COL_QA + 16 * s_ + 8 * hi); } \
        _Pragma("unroll") for (int ks_ = 0; ks_ < 4; ++ks_) { a0[ks_] = *(const u32x2*)(ap_ + 16 * ks_); a1[ks_] = *(const u32x2*)(ap_ + 16 * ks_ + 8); } \
        _Pragma("unroll") for (int g_ = 0; g_ < 4; ++g_) { const int dv0_ = 32 * db + 8 * g_ + 4 * hi; gv[g_] = *(const u32x2*)(qrow_ + COL_GA + dv0_); gn[g_] = *(const f32x4*)(C.in[9] + e * 512 + hd_ * AD + dv0_); } } while (0)
    if (C.bid < NB * AH * 32) P3_LOAD(C.bid);
    for (int item = C.bid; item < NB * AH * 32; item += C.G) { const int n = item & 31, hd = (item >> 5) & 3, b = item >> 7; const size_t tok0 = (size_t)b * SEQ + n * 64;
        bf16_t* qrow = BIG + (tok0 + 32 * tb + l31) * AB_IN + hd * AD;
#pragma unroll
        for (int i = 0; i < 2; ++i) { const int cidx = C.tid + 512 * i, row = cidx >> 4, ch = cidx & 15;
            *(LAS u32x4*)(L + ((row >> 3) * 4 + (ch >> 2)) * 512 + (row & 7) * 64 + (ch & 3) * 16) = vst[i]; }
        __syncthreads();
        f32x16 acc;
#pragma unroll
        for (int r = 0; r < 16; ++r) acc[r] = 0.f;
#pragma unroll
        for (int s = 0; s < 8; ++s) acc = __builtin_amdgcn_mfma_f32_32x32x16_bf16(sf[s], qf[s], acc, 0, 0, 0);
#pragma unroll
        for (int ks = 0; ks < 4; ++ks) {
            const v4i16_t v0 = tr_read(L + ((2 * ks) * 4 + db) * 512 + vlane), v1 = tr_read(L + ((2 * ks + 1) * 4 + db) * 512 + vlane);
            const bf16x8 vf = (bf16x8){v0[0], v0[1], v0[2], v0[3], v1[0], v1[1], v1[2], v1[3]};
            const bf16x8 af = __builtin_bit_cast(bf16x8, (u32x4){a0[ks].x, a0[ks].y, a1[ks].x, a1[ks].y});
            acc = __builtin_amdgcn_mfma_f32_32x32x16_bf16(vf, af, acc, 0, 0, 0); }
        float gg[4][4], gw[4][4];
#pragma unroll
        for (int g = 0; g < 4; ++g) { gg[g][0] = __uint_as_float(gv[g].x << 16); gg[g][1] = __uint_as_float(gv[g].x & 0xffff0000u); gg[g][2] = __uint_as_float(gv[g].y << 16); gg[g][3] = __uint_as_float(gv[g].y & 0xffff0000u);
#pragma unroll
            for (int e2 = 0; e2 < 4; ++e2) gw[g][e2] = gn[g][e2]; }
        float ss = 0.f;
#pragma unroll
        for (int r = 0; r < 16; ++r) ss += acc[r] * acc[r];
        ss += __shfl_xor(ss, 32);
        if (hi == 0) ssum[db * 64 + 32 * tb + l31] = ss;
        __syncthreads();
        if (item + C.G < NB * AH * 32) P3_LOAD(item + C.G);
        const int tl = 32 * tb + l31;
        const float rstd = rsqrtf(((ssum[tl] + ssum[64 + tl]) + (ssum[128 + tl] + ssum[192 + tl])) * (1.0f / AD) + EPS);
#pragma unroll
        for (int g = 0; g < 4; ++g) { const int dv0 = 32 * db + 8 * g + 4 * hi;
            u32x2 o; o.x = cvtpk(acc[4 * g] * rstd * gw[g][0] * (gg[g][0] * fast_sigmoid(gg[g][0])), acc[4 * g + 1] * rstd * gw[g][1] * (gg[g][1] * fast_sigmoid(gg[g][1])));
            o.y = cvtpk(acc[4 * g + 2] * rstd * gw[g][2] * (gg[g][2] * fast_sigmoid(gg[g][2])), acc[4 * g + 3] * rstd * gw[g][3] * (gg[g][3] * fast_sigmoid(gg[g][3])));
            *(u32x2*)(qrow + COL_QA + dv0) = o; }
        __syncthreads();
    }
#undef P3_LOAD
}

enum { K_PRO = 0, K_INPROJ = 1, K_MIXA = 2, K_MIXB = 3, K_MIXC = 4, K_OUTPROJ = 5, K_XQ = 6, K_XATTN = 7, K_XO = 8, K_UP = 9, K_DOWN = 10, K_FINAL = 11 };
constexpr unsigned long long EVEN_KINDS = 0xA987654321ull; constexpr int N_EVEN_PH = 10;
constexpr unsigned long long ODD_KINDS = 0xA9876531ull; constexpr int N_ODD_PH = 8;
constexpr int N_PHASES = 1 + 2 * (N_EVEN_PH + N_ODD_PH) + 1;

#ifndef PROBE_GEMM
#define PROBE_GEMM 1
#endif
#ifndef PROBE_SYNC
#define PROBE_SYNC 1
#endif
#ifndef PROBE_FOX
#define PROBE_FOX 0
#endif
#ifndef PROBE_BAND
#define PROBE_BAND 0
#endif
#ifndef PROBE_XATTN
#define PROBE_XATTN 0
#endif
#define GEMM_SCALE(MODE_, ACT_, M_, N_, K_, LDA_, A_, B_, O_, RS_) for (int rep_ = 0; rep_ < PROBE_GEMM; ++rep_) do { int t2_ = C.tid; asm volatile("" : "+v"(t2_)); pg8::Gemm g{A_, B_}; pg8::EpiScale<MODE_, ACT_, N_> E{O_, RS_}; pg8::StaticOrder S; S.init(M_, N_, C.G, C.bid); \
        pg8::gemm_phase<pg8::EpiScale<MODE_, ACT_, N_>, pg8::StaticOrder, K_, LDA_>(C.lds, g, S, E, t2_); } while (0)
#ifndef PROBE_XO
#define PROBE_XO 0
#endif
#define GEMM_RES(K_, LDA_, A_, B_, BASE_, NREP_) for (int rep_ = NREP_; rep_ >= 0; --rep_) do { int t2_ = C.tid; asm volatile("" : "+v"(t2_)); pg8::Gemm g{A_, B_}; \
        pg8::EpiRes E{HB, RSS}; pg8::StaticOrder S; S.init(T, D, C.G, C.bid); \
        pg8::gemm_phase<pg8::EpiRes, pg8::StaticOrder, K_, LDA_>(C.lds, g, S, E, t2_); } while (0)
#define XB_TMO      128
#define XB_XCNT(j)  (256  + 64 * (j))
#define XB_XSUB(j)  (1280 + 64 * (j))
#define XB_XGEN(j)  (2304 + 64 * (j))
#define XB_TOP      3328
#define XB_TOPGEN   3392
#define XCD_BAR_WORDS 3456
#define XB_SPIN_CAP (1u << 22)

__device__ __forceinline__ unsigned xb_ld(unsigned* p)              { return __hip_atomic_load(p, __ATOMIC_RELAXED, __HIP_MEMORY_SCOPE_AGENT); }
__device__ __forceinline__ unsigned xb_add(unsigned* p, unsigned v) { return __hip_atomic_fetch_add(p, v, __ATOMIC_RELAXED, __HIP_MEMORY_SCOPE_AGENT); }
__device__ __forceinline__ unsigned xb_xcc_id() { return (unsigned)__builtin_amdgcn_s_getreg((3 << 11) | 20) & 0xFu; }
#define XB_SPIN(cond, bar) do { unsigned _sp = 0; while (cond) { __builtin_amdgcn_s_sleep(1); \
    if ((++_sp & 255u) == 0u) { if (xb_ld(&(bar)[XB_TMO])) break; if (_sp > XB_SPIN_CAP) { atomicAdd(&(bar)[XB_TMO], 1u); break; } } } } while (0)

struct XcdBarrier {
    unsigned* bar; unsigned x;
    volatile LAS unsigned* st;
};

__device__ __forceinline__ XcdBarrier xcd_barrier_post(unsigned* bar, volatile LAS unsigned* st) {
    XcdBarrier b; b.bar = bar; b.x = xb_xcc_id(); b.st = st;
    if (threadIdx.x == 0) (void)xb_add(&bar[XB_XCNT(b.x)], 1u);
    return b;
}
__device__ __forceinline__ void xcd_barrier_complete(unsigned* bar, unsigned x, unsigned& nloc, unsigned& nx) {
    const unsigned G = gridDim.x * gridDim.y * gridDim.z;
    unsigned sum, cnt, mine, sp = 0u;
    for (;;) {
        sum = 0u; cnt = 0u; mine = 0u;
#pragma unroll
        for (unsigned j = 0; j < 16; ++j) { const unsigned c = xb_ld(&bar[XB_XCNT(j)]); sum += c; cnt += (c > 0u) ? 1u : 0u; mine = (j == x) ? c : mine; }
        if (sum == G) break;
        __builtin_amdgcn_s_sleep(1);
        if ((++sp & 255u) == 0u) { if (xb_ld(&bar[XB_TMO])) break; if (sp > XB_SPIN_CAP) { atomicAdd(&bar[XB_TMO], 1u); break; } }
    }
    nloc = mine > 0u ? mine : 1u; nx = cnt > 0u ? cnt : 1u;
}

__device__ __forceinline__ void xcd_barrier(const XcdBarrier& b) {
    asm volatile("s_waitcnt vmcnt(0)" ::: "memory");
    __syncthreads();
    if (threadIdx.x == 0) {
        unsigned* bar = b.bar;
        __builtin_amdgcn_s_waitcnt(0);
        unsigned nloc = b.st[0], nx = b.st[1];
        if (nloc == 0u) { xcd_barrier_complete(bar, b.x, nloc, nx); b.st[0] = nloc; b.st[1] = nx; }
        const unsigned old = xb_add(&bar[XB_XSUB(b.x)], 1u);
        const unsigned gen = old / nloc;
        if (old + 1u == (gen + 1u) * nloc) {
            __builtin_amdgcn_fence(__ATOMIC_RELEASE, "agent");
            asm volatile("s_waitcnt vmcnt(0)" ::: "memory");
            const unsigned og = xb_add(&bar[XB_TOP], 1u);
            const unsigned tg = og / nx;
            if (og + 1u == (tg + 1u) * nx) xb_add(&bar[XB_TOPGEN], 1u);
            else XB_SPIN(xb_ld(&bar[XB_TOPGEN]) == tg, bar);
            __builtin_amdgcn_fence(__ATOMIC_ACQUIRE, "agent");
            xb_add(&bar[XB_XGEN(b.x)], 1u);
            asm volatile("s_waitcnt vmcnt(0)" ::: "memory");
        } else {
            XB_SPIN(xb_ld(&bar[XB_XGEN(b.x)]) == gen, bar);
            __builtin_amdgcn_fence(__ATOMIC_ACQUIRE, "agent");
            asm volatile("s_waitcnt vmcnt(0)" ::: "memory");
        }
    }
    __syncthreads();
}

__global__ void __launch_bounds__(512, 2) mega(Args a) {
    extern __shared__ __attribute__((aligned(16))) unsigned char lds_raw[];
    Ctx C; C.lds = (LAS unsigned char*)lds_raw; C.tid = threadIdx.x;  C.G = gridDim.x; C.bid = blockIdx.x;
    C.in = a.in; C.out = a.out; C.ws = a.ws;
    cg::grid_group grid = cg::this_grid();
    volatile LAS unsigned* MISC = (volatile LAS unsigned*)(C.lds + LDS_BYTES - 64);
    if (threadIdx.x < 16) MISC[threadIdx.x] = 0u;
    __syncthreads();
    const XcdBarrier bar = xcd_barrier_post((unsigned*)a.ws, MISC);
#ifdef TS_MASK
    unsigned long long ts_last = __builtin_amdgcn_s_memrealtime(); unsigned ts_sum = 0u;
#endif
    for (int ph = a.ph_lo; ph < a.ph_hi; ++ph) {
        { int t_ = threadIdx.x; asm volatile("" : "+v"(t_)); C.tid = t_;  }
        { unsigned char* w_ = a.ws; asm volatile("" : "+s"(w_)); C.ws = w_; float* o_ = a.out; asm volatile("" : "+s"(o_)); C.out = o_;
          int b_ = blockIdx.x; asm volatile("" : "+v"(b_)); C.bid = __builtin_amdgcn_readfirstlane(b_); int g_ = gridDim.x; asm volatile("" : "+v"(g_)); C.G = __builtin_amdgcn_readfirstlane(g_); }
        int l = 0, kind;
        if (ph == 0) kind = K_PRO; else if (ph == N_PHASES - 1) kind = K_FINAL;
        else { const int r = ph - 1, pair = r / (N_EVEN_PH + N_ODD_PH), rr = r % (N_EVEN_PH + N_ODD_PH);
            if (rr < N_EVEN_PH) { l = 2 * pair; kind = (int)((EVEN_KINDS >> (4 * rr)) & 15ull); } else { l = 2 * pair + 1; kind = (int)((ODD_KINDS >> (4 * (rr - N_EVEN_PH))) & 15ull); } }
        const bool even = (l & 1) == 0;
        bf16_t* WB = WSP(bf16_t, WS_W0 + (size_t)(l & 1) * WS_WSTRIDE);
        bf16_t* HB = WSP(bf16_t, WS_HB); bf16_t* BIG = WSP(bf16_t, WS_BIG); float* RSS = WSP(float, WS_RSS);
        if (kind == K_PRO) prologue(C);
        else if (kind == K_FINAL) final_norm(C);
        else if (kind == K_INPROJ) {
            if (even) GEMM_SCALE(0, 0, T, AB_IN, D, D, HB, WB + WO_IN, BIG, RSS); else GEMM_SCALE(0, 0, T, C_INP, D, D, HB, WB + WO_IN, BIG, RSS);
        } else if (kind == K_XQ) {
            GEMM_SCALE(0, 0, T, D, D, D, HB, WB + WO_XQ, BIG, RSS);
            GEMM_SCALE(1, 0, TM, 2 * D, D, D, WSP(bf16_t, WS_MEMB), WB + WO_XKV, WSP(bf16_t, WS_MEMKV), WSP(float, WS_RSTDM));
        } else if (kind == K_UP) {
            GEMM_SCALE(0, 1, T, FF, D, D, HB, WB + WO_UP, BIG, RSS);
        } else if (kind == K_OUTPROJ) {
            const float* base = l == 0 ? C.in[0] : C.out;
            if (even) GEMM_RES(D, AB_IN, BIG, WB + WO_OUT, base, 0); else GEMM_RES(D, C_INP, BIG, WB + WO_OUT, base, 0);
        } else if (kind == K_XO) {
            GEMM_RES(D, D, BIG, WB + WO_XO, C.out, PROBE_XO);
        } else if (kind == K_DOWN) {
            GEMM_RES(FF, FF, BIG, WB + WO_DOWN, C.out, 0);
        } else if (kind == K_MIXA) {
            if (even) { hgrn_pass1(C, l >> 1); for (int rep_ = PROBE_BAND; rep_ >= 0; --rep_) { { int t_ = threadIdx.x; asm volatile("" : "+v"(t_)); C.tid = t_;  } band_phase(C, l >> 1, rep_ > 0); } }
        } else if (kind == K_MIXB) {
            if (even) hgrn_scan(C); else for (int rep_ = PROBE_FOX; rep_ >= 0; --rep_) { { int t_ = threadIdx.x; asm volatile("" : "+v"(t_)); C.tid = t_;  } fox_phase(C, l >> 1, rep_ > 0); }
        } else if (kind == K_MIXC) {
            hgrn_pass3(C, l >> 1);
        } else if (kind == K_XATTN) {
            for (int rep_ = PROBE_XATTN; rep_ >= 0; --rep_) { { int t_ = threadIdx.x; asm volatile("" : "+v"(t_)); C.tid = t_;  } xattn_phase(C, rep_ > 0); }
            __syncthreads();
            if (l + 1 < DEPTH) conv_layer(C, l + 1);
        }
        if (ph + 1 < a.ph_hi) for (int rep_ = 0; rep_ < PROBE_SYNC; ++rep_) { if (ph == 0) grid.sync(); else xcd_barrier(bar); }
#ifdef TS_MASK
        if (ph + 1 == a.ph_hi) xcd_barrier(bar);
        { const unsigned long long now_ = __builtin_amdgcn_s_memrealtime(); const int kbit = (kind == K_MIXB && even) ? 12 : kind;
          if ((TS_MASK >> kbit) & 1) ts_sum += (unsigned)(now_ - ts_last); ts_last = now_; }
#endif
    }
#ifdef TS_MASK
    if (C.bid == 0) { const unsigned nel = (unsigned)(((unsigned long long)ts_sum * 256ull) / 100ull); for (unsigned i = threadIdx.x; i < nel; i += 512) C.out[i] += 0.0625f; }
#endif
}

#ifndef SINGLE_LAUNCH
#define SINGLE_LAUNCH 1
#endif
extern "C" void kernel_launch(void* const* d_in, const int* in_sizes, int n_in, void* d_out, int out_size, void* d_ws, size_t ws_size, hipStream_t stream) {
    static int grid = 0;
    if (grid == 0) {
        if (n_in != 20 || out_size != T * D || ws_size < WS_END) { fprintf(stderr, "kernel_launch: unexpected shapes (n_in %d out %d ws %zu)\n", n_in, out_size, ws_size); grid = -1; return; }
        int dev = 0, cus = 0, per_cu = 0;
        hipGetDevice(&dev); hipDeviceGetAttribute(&cus, hipDeviceAttributeMultiprocessorCount, dev);
        if (hipFuncSetAttribute((const void*)mega, hipFuncAttributeMaxDynamicSharedMemorySize, LDS_BYTES) != hipSuccess) { fprintf(stderr, "kernel_launch: hipFuncSetAttribute failed\n"); grid = -1; return; }
        if (hipOccupancyMaxActiveBlocksPerMultiprocessor(&per_cu, (const void*)mega, 512, LDS_BYTES) != hipSuccess || per_cu < 1) { fprintf(stderr, "kernel_launch: occupancy query says %d\n", per_cu); per_cu = 1; }
        (void)hipGetLastError();
        grid = cus * 1;
    }
    if (grid < 0) return;
    Args a{};
    for (int i = 0; i < 20; ++i) a.in[i] = (const float*)d_in[i];
    a.out = (float*)d_out; a.ws = (unsigned char*)d_ws;
    if (hipMemsetAsync(d_ws, 0, 16384, stream) != hipSuccess) { fprintf(stderr, "kernel_launch: memset failed\n"); return; }
#if SINGLE_LAUNCH
    a.ph_lo = 0; a.ph_hi = N_PHASES;
    void* args[] = {&a};
    hipError_t e = hipLaunchCooperativeKernel((const void*)mega, dim3(grid), dim3(512), args, LDS_BYTES, stream);
    if (e != hipSuccess) fprintf(stderr, "cooperative launch failed: %s (grid %d)\n", hipGetErrorString(e), grid);
#else
    for (int ph = 0; ph < N_PHASES; ++ph) { a.ph_lo = ph; a.ph_hi = ph + 1; hipLaunchKernelGGL(mega, dim3(grid), dim3(512), LDS_BYTES, stream, a); }
#endif
}
```
